# Optimizing an MI355X kernel written in HIP

```python
import jax, jax.numpy as jnp
from jax import lax
import numpy as np

D_MODEL = 4096
BATCH = 4
SEQ = 2048
DEPTH = 1

GRID_W = 64

NA_HEADS = 16
NA_HEAD_DIM = 128
NA_KH_MAX = 8
NA_KW = 16
NA_QBLOCK_W = 16
NA_KBLOCK_W = 32

MLA_HEADS = 16
MLA_Q_RANK = 1024
MLA_KV_RANK = 512
MLA_NOPE_DIM = 128
MLA_ROPE_DIM = 64
MLA_V_DIM = 128
ROPE_THETA = 10000.0
Q_BLOCK = 128

MEM_LEN = 256
MEM_HEADS = 4
MEM_HEAD_DIM = 128

D_FF = 256 * ((8 * D_MODEL // 3 + 255) // 256)
FFN_RES_WEIGHT = 0.5

NORM_EPS = 1e-6
NEG_INF = -1e30

NA_WIDTH = NA_HEADS * NA_HEAD_DIM
MLA_WIDTH = MLA_HEADS * MLA_V_DIM
MIX_WIDTH = NA_WIDTH + MLA_WIDTH
IN_PROJ_WIDTH = 3 * NA_WIDTH + MLA_Q_RANK + MLA_KV_RANK + MLA_ROPE_DIM
MEM_WIDTH = MEM_HEADS * MEM_HEAD_DIM

kernel_name = "hybrid_natten_mla_macaron_layer"


def rms_norm(x, g):
    xf = x.astype(jnp.float32)
    y = xf * lax.rsqrt(jnp.mean(xf * xf, axis=-1, keepdims=True) + NORM_EPS)
    return (y * g.astype(jnp.float32)).astype(x.dtype)


def swiglu(x, w_gate, w_up, w_down):
    return (jax.nn.silu(x @ w_gate) * (x @ w_up)) @ w_down


def rope(x, positions):
    half = MLA_ROPE_DIM // 2
    inv_freq = 1.0 / (ROPE_THETA ** (jnp.arange(half, dtype=jnp.float32) / half))
    ang = positions.astype(jnp.float32)[..., None] * inv_freq
    ang = ang.reshape(ang.shape[:2] + (1,) * (x.ndim - 3) + (half,))
    cos, sin = jnp.cos(ang), jnp.sin(ang)
    xf = x.astype(jnp.float32)
    x1, x2 = xf[..., :half], xf[..., half:]
    out = jnp.concatenate([x1 * cos - x2 * sin, x2 * cos + x1 * sin], axis=-1)
    return out.astype(x.dtype)


def neighborhood_attention(q, k, v, rpb):
    B, S, H, Dh = q.shape
    rows = S // GRID_W
    kh = min(NA_KH_MAX, rows)
    n_cb = GRID_W // NA_QBLOCK_W
    scale = Dh ** -0.5

    qg = jnp.moveaxis(q.reshape(B, rows, n_cb, NA_QBLOCK_W, H, Dh), 1, 0)
    kg = k.reshape(B, rows, GRID_W, H, Dh)
    vg = v.reshape(B, rows, GRID_W, H, Dh)

    qcol = np.arange(GRID_W).reshape(n_cb, NA_QBLOCK_W)
    cstart = np.clip(qcol - NA_KW // 2, 0, GRID_W - NA_KW)
    kb_start = np.clip(np.arange(n_cb) * NA_QBLOCK_W - NA_KW // 2, 0, GRID_W - NA_KBLOCK_W)
    kcol = kb_start[:, None] + np.arange(NA_KBLOCK_W)
    col_in = (kcol[:, None, :] >= cstart[:, :, None]) & (kcol[:, None, :] < cstart[:, :, None] + NA_KW)
    col_idx = np.clip(kcol[:, None, :] - qcol[:, :, None] + NA_KW - 1, 0, 2 * NA_KW - 2)
    mask = np.broadcast_to(col_in[:, :, None, :], (n_cb, NA_QBLOCK_W, kh, NA_KBLOCK_W))
    mask = jnp.asarray(mask.reshape(n_cb, NA_QBLOCK_W, kh * NA_KBLOCK_W))

    def row_block(args):
        r, q_r = args
        rs = jnp.clip(r - kh // 2, 0, rows - kh)
        k_rows = lax.dynamic_slice_in_dim(kg, rs, kh, axis=1)
        v_rows = lax.dynamic_slice_in_dim(vg, rs, kh, axis=1)
        k_blk = jnp.transpose(k_rows[:, :, kcol], (0, 2, 1, 3, 4, 5)).reshape(B, n_cb, kh * NA_KBLOCK_W, H, Dh)
        v_blk = jnp.transpose(v_rows[:, :, kcol], (0, 2, 1, 3, 4, 5)).reshape(B, n_cb, kh * NA_KBLOCK_W, H, Dh)
        s = jnp.einsum('bjqhd,bjkhd->bhjqk', q_r, k_blk).astype(jnp.float32) * scale
        row_idx = rs + jnp.arange(kh) - r + NA_KH_MAX - 1
        bias = rpb[:, row_idx][:, :, col_idx]
        bias = jnp.transpose(bias, (0, 2, 3, 1, 4)).reshape(H, n_cb, NA_QBLOCK_W, kh * NA_KBLOCK_W)
        s = jnp.where(mask, s + bias.astype(jnp.float32), NEG_INF)
        p = jax.nn.softmax(s, axis=-1).astype(v.dtype)
        o = jnp.einsum('bhjqk,bjkhd->bjqhd', p, v_blk)
        return o.reshape(B, GRID_W, H, Dh)

    out = lax.map(row_block, (jnp.arange(rows), qg))
    return jnp.moveaxis(out, 0, 1).reshape(B, S, H * Dh)


def latent_attention(c_q, c_kv, k_rope_in, positions, g_q_a, w_q_b, g_kv_a, w_kv_b):
    B, S, _ = c_q.shape
    H = MLA_HEADS
    q = (rms_norm(c_q, g_q_a) @ w_q_b).reshape(B, S, H, MLA_NOPE_DIM + MLA_ROPE_DIM)
    q_nope, q_pe = q[..., :MLA_NOPE_DIM], rope(q[..., MLA_NOPE_DIM:], positions)
    kv = (rms_norm(c_kv, g_kv_a) @ w_kv_b).reshape(B, S, H, MLA_NOPE_DIM + MLA_V_DIM)
    k_nope, v = kv[..., :MLA_NOPE_DIM], kv[..., MLA_NOPE_DIM:]
    k_pe = rope(k_rope_in, positions)
    scale = (MLA_NOPE_DIM + MLA_ROPE_DIM) ** -0.5
    nb = S // Q_BLOCK
    qn_b = jnp.moveaxis(q_nope.reshape(B, nb, Q_BLOCK, H, MLA_NOPE_DIM), 1, 0)
    qp_b = jnp.moveaxis(q_pe.reshape(B, nb, Q_BLOCK, H, MLA_ROPE_DIM), 1, 0)

    def q_block(args):
        qn, qp = args
        s = (jnp.einsum('bqhd,bkhd->bhqk', qn, k_nope)
             + jnp.einsum('bqhr,bkr->bhqk', qp, k_pe)).astype(jnp.float32) * scale
        p = jax.nn.softmax(s, axis=-1).astype(v.dtype)
        return jnp.einsum('bhqk,bkhd->bqhd', p, v)

    out = lax.map(q_block, (qn_b, qp_b))
    return jnp.moveaxis(out, 0, 1).reshape(B, S, MLA_WIDTH)


def memory_cross_attention(h, mem_n, w_q, w_kv, w_o):
    B, S, _ = h.shape
    M = mem_n.shape[1]
    q = (h @ w_q).reshape(B, S, MEM_HEADS, MEM_HEAD_DIM)
    kv = (mem_n @ w_kv).reshape(B, M, MEM_HEADS, 2 * MEM_HEAD_DIM)
    k, v = kv[..., :MEM_HEAD_DIM], kv[..., MEM_HEAD_DIM:]
    s = jnp.einsum('bqhd,bkhd->bhqk', q, k).astype(jnp.float32) * (MEM_HEAD_DIM ** -0.5)
    p = jax.nn.softmax(s, axis=-1).astype(v.dtype)
    o = jnp.einsum('bhqk,bkhd->bqhd', p, v).reshape(B, S, MEM_WIDTH)
    return o @ w_o


def setup_inputs(seed: int = 0) -> dict:
    key = jax.random.key(seed)
    ks = jax.random.split(key, 32)

    def w(k, shape, fan_in):
        return jax.random.normal(k, shape, jnp.float32) * (fan_in ** -0.5)

    def gain(k, shape):
        return 1.0 + 0.01 * jax.random.normal(k, shape, jnp.float32)

    L, D = DEPTH, D_MODEL
    return {
        "x": jax.random.normal(ks[0], (BATCH, SEQ, D), jnp.float32),
        "mem": jax.random.normal(ks[1], (BATCH, MEM_LEN, D), jnp.float32),
        "positions": jnp.broadcast_to(jnp.arange(SEQ, dtype=jnp.int32), (BATCH, SEQ)),
        "ffn1_w_gate": w(ks[2], (L, D, D_FF), D),
        "ffn1_w_up": w(ks[3], (L, D, D_FF), D),
        "ffn1_w_down": w(ks[4], (L, D_FF, D), D_FF),
        "g_ffn1": gain(ks[5], (L, 2, D)),
        "w_in": w(ks[6], (L, D, IN_PROJ_WIDTH), D),
        "g_q_a": gain(ks[7], (L, MLA_Q_RANK)),
        "w_q_b": w(ks[8], (L, MLA_Q_RANK, MLA_HEADS * (MLA_NOPE_DIM + MLA_ROPE_DIM)), MLA_Q_RANK),
        "g_kv_a": gain(ks[9], (L, MLA_KV_RANK)),
        "w_kv_b": w(ks[10], (L, MLA_KV_RANK, MLA_HEADS * (MLA_NOPE_DIM + MLA_V_DIM)), MLA_KV_RANK),
        "na_rpb": 0.02 * jax.random.normal(ks[11], (L, NA_HEADS, 2 * NA_KH_MAX - 1, 2 * NA_KW - 1), jnp.float32),
        "w_out": w(ks[12], (L, MIX_WIDTH, D), MIX_WIDTH),
        "g_mix": gain(ks[13], (L, 2, D)),
        "g_mem_in": gain(ks[14], (L, D)),
        "w_mem_q": w(ks[15], (L, D, MEM_WIDTH), D),
        "w_mem_kv": w(ks[16], (L, D, 2 * MEM_WIDTH), D),
        "w_mem_o": w(ks[17], (L, MEM_WIDTH, D), MEM_WIDTH),
        "g_mem_attn": gain(ks[18], (L, 2, D)),
        "ffn2_w_gate": w(ks[19], (L, D, D_FF), D),
        "ffn2_w_up": w(ks[20], (L, D, D_FF), D),
        "ffn2_w_down": w(ks[21], (L, D_FF, D), D_FF),
        "g_ffn2": gain(ks[22], (L, 2, D)),
        "g_final": gain(ks[23], (L, D)),
    }


def reference(x, mem, positions,
              ffn1_w_gate, ffn1_w_up, ffn1_w_down, g_ffn1,
              w_in, g_q_a, w_q_b, g_kv_a, w_kv_b, na_rpb, w_out, g_mix,
              g_mem_in, w_mem_q, w_mem_kv, w_mem_o, g_mem_attn,
              ffn2_w_gate, ffn2_w_up, ffn2_w_down, g_ffn2,
              g_final):
    B, S, _ = x.shape
    splits = list(np.cumsum([NA_WIDTH, NA_WIDTH, NA_WIDTH, MLA_Q_RANK, MLA_KV_RANK]))
    h = x
    for l in range(DEPTH):
        f = swiglu(rms_norm(h, g_ffn1[l, 0]), ffn1_w_gate[l], ffn1_w_up[l], ffn1_w_down[l])
        h = h + FFN_RES_WEIGHT * rms_norm(f, g_ffn1[l, 1])

        u = rms_norm(h, g_mix[l, 0])
        q_na, k_na, v_na, c_q, c_kv, k_rope_in = jnp.split(u @ w_in[l], splits, axis=-1)
        hd = (B, S, NA_HEADS, NA_HEAD_DIM)
        o_na = neighborhood_attention(q_na.reshape(hd), k_na.reshape(hd), v_na.reshape(hd), na_rpb[l])
        o_mla = latent_attention(c_q, c_kv, k_rope_in, positions, g_q_a[l], w_q_b[l], g_kv_a[l], w_kv_b[l])
        o = jnp.concatenate([o_na, o_mla], axis=-1) @ w_out[l]
        h = h + rms_norm(o, g_mix[l, 1])

        a = memory_cross_attention(rms_norm(h, g_mem_attn[l, 0]), rms_norm(mem, g_mem_in[l]),
                                   w_mem_q[l], w_mem_kv[l], w_mem_o[l])
        h = h + rms_norm(a, g_mem_attn[l, 1])

        f = swiglu(rms_norm(h, g_ffn2[l, 0]), ffn2_w_gate[l], ffn2_w_up[l], ffn2_w_down[l])
        h = h + FFN_RES_WEIGHT * rms_norm(f, g_ffn2[l, 1])

        h = rms_norm(h, g_final[l])
    return h
```

```cpp
#include <hip/hip_runtime.h>
#include <cstdio>
#include <cstdint>

#ifndef MK_N_LAUNCHES
#define MK_N_LAUNCHES 16
#endif

#define LAS __attribute__((address_space(3)))
#define GAS __attribute__((address_space(1)))
typedef unsigned short bf16_t;
typedef __attribute__((address_space(1))) unsigned short gbf16;
typedef __attribute__((address_space(1))) float gf32;
typedef __attribute__((address_space(1))) unsigned char gu8;
typedef short bf16x8 __attribute__((ext_vector_type(8)));
typedef short s16x4 __attribute__((ext_vector_type(4)));
typedef float f32x2 __attribute__((ext_vector_type(2)));
typedef float f32x4 __attribute__((ext_vector_type(4)));
typedef float f32x16 __attribute__((ext_vector_type(16)));
typedef unsigned u32x2 __attribute__((ext_vector_type(2)));
typedef unsigned u32x4 __attribute__((ext_vector_type(4)));

constexpr int D = 4096, BATCH = 4, SEQ = 2048, M = BATCH * SEQ, DFF = 11008;
constexpr int NAW = 2048, QRANK = 1024, KVRANK = 512, ROPED = 64, INW = 3 * NAW + QRANK + KVRANK + ROPED  , INWP = 7936  ;
constexpr int NHEAD = 16, MLA_QD = 192, MLA_KVD = 256, QBW = NHEAD * MLA_QD  , KVBW = NHEAD * MLA_KVD  ;
constexpr int MEMLEN = 256, MEMROWS = BATCH * MEMLEN, MEMW = 512;
constexpr float EPS = 1e-6f, LOG2E = 1.4426950408889634f;
constexpr int NWAVES = 8, NTHREADS = 512;

constexpr size_t MiB = 1u << 20;
constexpr size_t WS_CTL = 0, CTL_ZERO_BYTES = 64 * 1024;
constexpr size_t WS_WGU1 = 1 * MiB, WS_WD1 = WS_WGU1 + 172 * MiB, WS_WGU2 = WS_WD1 + 86 * MiB, WS_WD2 = WS_WGU2 + 172 * MiB, WS_WIN = WS_WD2 + 86 * MiB;
constexpr size_t WS_WQB = WS_WIN + 62 * MiB, WS_WKVB = WS_WQB + 6 * MiB, WS_WOUT = WS_WKVB + 4 * MiB, WS_WMQ = WS_WOUT + 32 * MiB, WS_WMKV = WS_WMQ + 4 * MiB, WS_WMO = WS_WMKV + 8 * MiB;
constexpr size_t WS_H = WS_WMO + 4 * MiB;
constexpr size_t WS_XN = WS_H + 128 * MiB;
constexpr size_t WS_ACT = WS_XN + 64 * MiB;
constexpr size_t WS_F = WS_ACT + 172 * MiB;
constexpr size_t WS_SS = WS_F + 64 * MiB;
constexpr size_t WS_SSQ = WS_SS + 2 * MiB;
constexpr size_t WS_KPE = WS_SSQ + 1 * MiB;
constexpr size_t WS_MEMN = WS_KPE + 1 * MiB;
constexpr size_t WS_KVM = WS_MEMN + 8 * MiB;
constexpr size_t WS_QM = WS_KVM + 2 * MiB;
constexpr size_t WS_OM = WS_QM + 8 * MiB;
constexpr size_t WS_ROPE = WS_OM + 8 * MiB;
constexpr size_t WS_END = WS_ROPE + 2 * MiB;
constexpr size_t WS_U = WS_ACT, WS_QMLA = WS_ACT + 124 * MiB, WS_KVMLA = WS_F, WS_OCAT = WS_XN;
static_assert((size_t)22016 * 4096 * 2 == 172 * MiB && (size_t)4096 * 11008 * 2 == 86 * MiB && (size_t)INWP * 4096 * 2 == 62 * MiB && (size_t)M * INWP * 2 == 124 * MiB, "ws map");
constexpr int CW_BAR = 1024;

constexpr int RING_BYTES = 143360;
constexpr int MISC_OFF = RING_BYTES + 320;
constexpr int LDS_BYTES = 147456;

#define LDS_WAIT() asm volatile("s_waitcnt lgkmcnt(0)" ::: "memory")
#define VM_WAIT() asm volatile("s_waitcnt vmcnt(0)" ::: "memory")
__device__ __forceinline__ unsigned cvt_pk_bf16(float lo, float hi) { unsigned r; asm volatile("v_cvt_pk_bf16_f32 %0, %1, %2" : "=v"(r) : "v"(lo), "v"(hi)); return r; }
__device__ __forceinline__ float bf_lo(unsigned w) { return __uint_as_float(w << 16); }
__device__ __forceinline__ float bf_hi(unsigned w) { return __uint_as_float(w & 0xffff0000u); }
__device__ __forceinline__ float wave_sum(float v) {
#pragma unroll
    for (int o = 1; o < 64; o <<= 1) v += __shfl_xor(v, o);
    return v;
}

namespace pg8 {
constexpr int BM = 256, BK = 64, HALF = 128, HTB = HALF * BK * 2, STAGE_BYTES = 8 * HTB, NXCD = 8, WGM = 8;
__host__ __device__ __forceinline__ int lds_byte(int r, int c) { const int st = (r >> 4) * 2 + (c >> 5), rr = r & 15, cc = c & 31, ob = rr * 64 + cc * 2; return st * 1024 + (ob ^ (((ob >> 9) & 1) << 5)); }
__host__ __device__ __forceinline__ void stage_rc(int b, int& R, int& C) { const int st = b / 1024, sb = b % 1024, swz = sb ^ (((sb >> 9) & 1) << 5); R = (st >> 1) * 16 + swz / 64; C = (st & 1) * 32 + (swz % 64) / 2; }
__host__ __device__ __forceinline__ int perm32(int rho) { const int n = rho >> 4, i = rho & 15; return 8 * (i >> 2) + 4 * n + (i & 3); }

struct Unit { int pm, pn; };
struct Gemm { const gbf16* A; const gbf16* Bt; int M, N, K, lda, ldb; };

struct StaticOrder {
    int nM, nN, nwg, G, c;
    __host__ __device__ void init(int M_, int N_, int G_, int c_) { nM = M_ / BM; nN = N_ / BM; nwg = nM * nN; G = G_; c = c_; }
    __host__ __device__ bool next(int i, Unit& u) const {
        const long L = (long)i * G + c; if (L >= nwg) return false;
        int wgid = (int)L; { const int q = nwg / NXCD, r = nwg % NXCD, xcd = wgid % NXCD, off = wgid / NXCD; wgid = (xcd < r ? xcd * (q + 1) : r * (q + 1) + (xcd - r) * q) + off; }
        const int nig = WGM * nN, gid = wgid / nig, fm = gid * WGM, gsz = (nM - fm) < WGM ? (nM - fm) : WGM;
        u.pm = fm + ((wgid % nig) % gsz); u.pn = (wgid % nig) / gsz; return true;
    }
    __device__ __forceinline__ void a_ready(const Unit&) const {}
    __device__ __forceinline__ void done(const Unit&) const {}
};

__device__ __forceinline__ u32x4 pack8(const f32x4 v0, const f32x4 v1) { u32x4 w; w.x = cvt_pk_bf16(v0[0], v0[1]); w.y = cvt_pk_bf16(v0[2], v0[3]); w.z = cvt_pk_bf16(v1[0], v1[1]); w.w = cvt_pk_bf16(v1[2], v1[3]); return w; }
__device__ __forceinline__ float sq8(const f32x4 a, const f32x4 b) { return (a[0] * a[0] + a[1] * a[1]) + (a[2] * a[2] + a[3] * a[3]) + (b[0] * b[0] + b[1] * b[1]) + (b[2] * b[2] + b[3] * b[3]); }
__device__ __forceinline__ float silu_f(float g) { return g * __builtin_amdgcn_rcpf(1.0f + __builtin_amdgcn_exp2f(-LOG2E * g)); }
__device__ __forceinline__ void rope8(f32x4& v0, f32x4& v1, const GAS f32x2* cs) {
    const f32x4 c01 = *(const GAS f32x4*)cs, c23 = *(const GAS f32x4*)(cs + 2);
    f32x4 o0, o1;
    o0[0] = v0[0] * c01[0] - v0[1] * c01[1]; o0[1] = v0[1] * c01[0] + v0[0] * c01[1];
    o0[2] = v0[2] * c01[2] - v0[3] * c01[3]; o0[3] = v0[3] * c01[2] + v0[2] * c01[3];
    o1[0] = v1[0] * c23[0] - v1[1] * c23[1]; o1[1] = v1[1] * c23[0] + v1[0] * c23[1];
    o1[2] = v1[2] * c23[2] - v1[3] * c23[3]; o1[3] = v1[3] * c23[2] + v1[2] * c23[3];
    v0 = o0; v1 = o1;
}

struct EpiSwiglu {
    static constexpr bool PERM = true, AFTER_DRAIN = false;
    gbf16* O; int ldc;
    __device__ __forceinline__ void operator()(const f32x4 (&acc)[2][2][4][2], const Unit& u, int wr, int wc, int fr, int fq) const {
        const int row0 = u.pm * BM + wr * 64 + fr, col0 = u.pn * HALF + wc * 32 + 8 * fq;
#pragma unroll
        for (int ai = 0; ai < 2; ++ai)
#pragma unroll
            for (int m = 0; m < 4; ++m) { gbf16* rowp = O + (size_t)(row0 + ai * HALF + m * 16) * ldc + col0;
                f32x4 v0, v1;
#pragma unroll
                for (int e = 0; e < 4; ++e) { v0[e] = silu_f(acc[ai][0][m][0][e]) * acc[ai][1][m][0][e]; v1[e] = silu_f(acc[ai][0][m][1][e]) * acc[ai][1][m][1][e]; }
                *(GAS u32x4*)rowp = pack8(v0, v1); }
    }
};
struct EpiF {
    static constexpr bool PERM = true, AFTER_DRAIN = false;
    gbf16* O; int ldc; gf32* SS; int ldss; float scale;
    __device__ __forceinline__ void operator()(const f32x4 (&acc)[2][2][4][2], const Unit& u, int wr, int wc, int fr, int fq) const {
        const int row0 = u.pm * BM + wr * 64 + fr, col0 = u.pn * BM + wc * 32 + 8 * fq;
#pragma unroll
        for (int ai = 0; ai < 2; ++ai)
#pragma unroll
            for (int m = 0; m < 4; ++m) { const int row = row0 + ai * HALF + m * 16; gbf16* rowp = O + (size_t)row * ldc + col0; float s = 0.f;
#pragma unroll
                for (int bj = 0; bj < 2; ++bj) { const f32x4 v0 = acc[ai][bj][m][0], v1 = acc[ai][bj][m][1]; s += sq8(v0, v1); *(GAS u32x4*)(rowp + bj * HALF) = pack8(v0 * scale, v1 * scale); }
                if (SS) { s += __shfl_xor(s, 16); s += __shfl_xor(s, 32); if (fq == 0) SS[(size_t)row * ldss + u.pn * 4 + wc] = s; } }
    }
};
struct EpiInProj {
    static constexpr bool PERM = true, AFTER_DRAIN = false;
    gbf16* U; gf32* SSQ; gf32* SSKV; gbf16* KPE; const GAS f32x2* ROPE; float qscale;
    __device__ __forceinline__ void operator()(const f32x4 (&acc)[2][2][4][2], const Unit& u, int wr, int wc, int fr, int fq) const {
        const int row0 = u.pm * BM + wr * 64 + fr, pn = u.pn;
        if (pn < 30) {
            const float sc = pn < 8 ? qscale : 1.0f; const int col0 = pn * BM + wc * 32 + 8 * fq;
            gf32* ssp = nullptr; int ldss = 0;
            if (pn >= 24 && pn < 28) { ssp = SSQ + (pn - 24) * 4 + wc; ldss = 16; } else if (pn >= 28) { ssp = SSKV + (pn - 28) * 4 + wc; ldss = 8; }
#pragma unroll
            for (int ai = 0; ai < 2; ++ai)
#pragma unroll
                for (int m = 0; m < 4; ++m) { const int row = row0 + ai * HALF + m * 16; gbf16* rowp = U + (size_t)row * INWP + col0; float s = 0.f;
#pragma unroll
                    for (int bj = 0; bj < 2; ++bj) { const f32x4 v0 = acc[ai][bj][m][0], v1 = acc[ai][bj][m][1]; s += sq8(v0, v1); *(GAS u32x4*)(rowp + bj * HALF) = pack8(v0 * sc, v1 * sc); }
                    if (ssp) { s += __shfl_xor(s, 16); s += __shfl_xor(s, 32); if (fq == 0) ssp[(size_t)row * ldss] = s; } }
        } else if (wc < 2) {
#pragma unroll
            for (int ai = 0; ai < 2; ++ai)
#pragma unroll
                for (int m = 0; m < 4; ++m) { const int row = row0 + ai * HALF + m * 16; f32x4 v0 = acc[ai][0][m][0], v1 = acc[ai][0][m][1];
                    rope8(v0, v1, ROPE + (size_t)row * 32 + 16 * wc + 4 * fq);
                    *(GAS u32x4*)(KPE + (size_t)row * 64 + 32 * wc + 8 * fq) = pack8(v0, v1); }
        }
    }
};
struct EpiQb {
    static constexpr bool PERM = true, AFTER_DRAIN = false;
    gbf16* O; const gf32* SSQ; const GAS f32x2* ROPE; float scale;
    __device__ __forceinline__ void operator()(const f32x4 (&acc)[2][2][4][2], const Unit& u, int wr, int wc, int fr, int fq) const {
        const int row0 = u.pm * BM + wr * 64 + fr;
#pragma unroll
        for (int ai = 0; ai < 2; ++ai)
#pragma unroll
            for (int m = 0; m < 4; ++m) { const int row = row0 + ai * HALF + m * 16;
                const GAS f32x4* sp = (const GAS f32x4*)(SSQ + (size_t)row * 16); const f32x4 a = sp[0], b = sp[1], c = sp[2], d = sp[3];
                const float ss = ((a[0] + a[1]) + (a[2] + a[3])) + ((b[0] + b[1]) + (b[2] + b[3])) + ((c[0] + c[1]) + (c[2] + c[3])) + ((d[0] + d[1]) + (d[2] + d[3]));
                const float rs = rsqrtf(ss * (1.0f / QRANK) + EPS) * scale;
#pragma unroll
                for (int bj = 0; bj < 2; ++bj) { const int cw = u.pn * BM + bj * HALF + wc * 32, jw = cw % MLA_QD;
                    f32x4 v0 = acc[ai][bj][m][0] * rs, v1 = acc[ai][bj][m][1] * rs;
                    if (jw >= 128) rope8(v0, v1, ROPE + (size_t)row * 32 + ((jw - 128) >> 1) + 4 * fq);
                    *(GAS u32x4*)(O + (size_t)row * QBW + cw + 8 * fq) = pack8(v0, v1); } }
    }
};
struct EpiKvb {
    static constexpr bool PERM = true, AFTER_DRAIN = false;
    gbf16* O; const gf32* SSKV;
    __device__ __forceinline__ void operator()(const f32x4 (&acc)[2][2][4][2], const Unit& u, int wr, int wc, int fr, int fq) const {
        const int row0 = u.pm * BM + wr * 64 + fr, col0 = u.pn * BM + wc * 32 + 8 * fq;
#pragma unroll
        for (int ai = 0; ai < 2; ++ai)
#pragma unroll
            for (int m = 0; m < 4; ++m) { const int row = row0 + ai * HALF + m * 16;
                const GAS f32x4* sp = (const GAS f32x4*)(SSKV + (size_t)row * 8); const f32x4 a = sp[0], b = sp[1];
                const float ss = ((a[0] + a[1]) + (a[2] + a[3])) + ((b[0] + b[1]) + (b[2] + b[3]));
                const float rs = rsqrtf(ss * (1.0f / KVRANK) + EPS);
#pragma unroll
                for (int bj = 0; bj < 2; ++bj) *(GAS u32x4*)(O + (size_t)row * KVBW + col0 + bj * HALF) = pack8(acc[ai][bj][m][0] * rs, acc[ai][bj][m][1] * rs); }
    }
};

template <class Epi, class Sched, bool ALIGN_EPI = true>
__device__ __forceinline__ void gemm_phase(LAS unsigned char* lds, const Gemm g, const Sched& S, const Epi& E) {
    const int tid = threadIdx.x, wid = __builtin_amdgcn_readfirstlane(tid >> 6), lane = tid & 63, wr = wid >> 2, wc = wid & 3, fr = lane & 15, fq = lane >> 4;
    const int K = g.K, nt = K / BK;
    unsigned voffA[2], voffB[2];
#pragma unroll
    for (int i = 0; i < 2; ++i) { int R, C; stage_rc(tid * 16 + i * 8192, R, C); const int Rb = Epi::PERM ? ((R & ~31) + perm32(R & 31)) : R;
        voffA[i] = (unsigned)(R * g.lda + C) * 2u; voffB[i] = (unsigned)(Rb * g.ldb + C) * 2u; }
    const size_t kstep = (size_t)(BK * 2);
    const size_t hA = (size_t)HALF * g.lda * 2, hB = (size_t)HALF * g.ldb * 2, tA = 2 * hA, tB = 2 * hB;
    const unsigned ldsw = (unsigned)wid * 1024u;
    const int aoff = lds_byte(wr * 64 + fr, fq * 8), boff = lds_byte(wc * 32 + fr, fq * 8);
#define PG8_SA(b, h) (((b) * 2 + (h)) * HTB)
#define PG8_SB(b, h) ((4 + (b) * 2 + (h)) * HTB)
#define PG8_STAGE(bufoff, gbase, voff) do { _Pragma("unroll") for (int _i = 0; _i < 2; ++_i) \
        __builtin_amdgcn_global_load_lds((const GAS unsigned*)((const GAS char*)(gbase) + (voff)[_i]), (LAS unsigned*)(lds + (bufoff) + ldsw + _i * 8192), 16, 0, 0); } while (0)
#define PG8_LDA(dst, b, h) do { _Pragma("unroll") for (int m = 0; m < 4; ++m) _Pragma("unroll") for (int k = 0; k < 2; ++k) dst[m][k] = *(const LAS bf16x8*)(lds + PG8_SA(b, h) + aoff + m * 2048 + k * 1024); } while (0)
#define PG8_LDB(dst, b, h) do { _Pragma("unroll") for (int n = 0; n < 2; ++n) _Pragma("unroll") for (int k = 0; k < 2; ++k) dst[n][k] = *(const LAS bf16x8*)(lds + PG8_SB(b, h) + boff + n * 2048 + k * 1024); } while (0)
#define PG8_MMA(ai, bj, At, Bt) do { __builtin_amdgcn_s_setprio(1); _Pragma("unroll") for (int m = 0; m < 4; ++m) _Pragma("unroll") for (int n = 0; n < 2; ++n) _Pragma("unroll") for (int k = 0; k < 2; ++k) \
        acc[ai][bj][m][n] = __builtin_amdgcn_mfma_f32_16x16x32_bf16(Bt[n][k], At[m][k], acc[ai][bj][m][n], 0, 0, 0); __builtin_amdgcn_s_setprio(0); } while (0)
#define PG8_WAIT_V(n) asm volatile("s_waitcnt vmcnt(" #n ")" ::: "memory")
#define PG8_WAIT_L(n) asm volatile("s_waitcnt lgkmcnt(" #n ")" ::: "memory")
#define PG8_BAR __builtin_amdgcn_s_barrier()
#define PG8_SCHED __builtin_amdgcn_sched_barrier(0)
    Unit cur, nxt; int ui = 0;
    if (!S.next(0, cur)) return;
    f32x4 acc[2][2][4][2];
#pragma unroll
    for (int a = 0; a < 2; ++a)
#pragma unroll
        for (int b = 0; b < 2; ++b)
#pragma unroll
            for (int m = 0; m < 4; ++m)
#pragma unroll
                for (int n = 0; n < 2; ++n) acc[a][b][m][n] = (f32x4){0.f, 0.f, 0.f, 0.f};
    bf16x8 At[4][2], B0[2][2], B1[2][2];
    const GAS char* cA = (const GAS char*)g.A + (size_t)cur.pm * tA; const GAS char* cB = (const GAS char*)g.Bt + (size_t)cur.pn * tB;
    S.a_ready(cur);
    PG8_STAGE(PG8_SB(0, 0), cB, voffB); PG8_STAGE(PG8_SB(0, 1), cB + hB, voffB); PG8_STAGE(PG8_SA(0, 0), cA, voffA); PG8_STAGE(PG8_SA(0, 1), cA + hA, voffA);
    if (wr == 1) PG8_BAR;
    PG8_WAIT_V(2); PG8_BAR;
    PG8_STAGE(PG8_SB(1, 0), cB + kstep, voffB); PG8_STAGE(PG8_SA(1, 0), cA + kstep, voffA); PG8_STAGE(PG8_SB(1, 1), cB + hB + kstep, voffB);
    PG8_WAIT_V(6); PG8_BAR;
    for (;;) {
        const bool has_next = S.next(ui + 1, nxt);
        const GAS char* nA = has_next ? (const GAS char*)g.A + (size_t)nxt.pm * tA : cA; const GAS char* nB = has_next ? (const GAS char*)g.Bt + (size_t)nxt.pn * tB : cB;
        for (int t = 0; t < nt; t += 2) {
            const bool last = (t == nt - 2);
            const GAS char* a1 = cA + (size_t)(t + 1) * kstep;
            const GAS char* a2 = last ? nA : cA + (size_t)(t + 2) * kstep; const GAS char* b2 = last ? nB : cB + (size_t)(t + 2) * kstep;
            const GAS char* a3 = a2 + kstep; const GAS char* b3 = b2 + kstep;
            if (last && has_next) S.a_ready(nxt);
            PG8_LDB(B0, 0, 0); PG8_LDB(B1, 0, 1); PG8_SCHED; PG8_LDA(At, 0, 0); PG8_STAGE(PG8_SA(1, 1), a1 + hA, voffA);
            PG8_WAIT_V(8); PG8_WAIT_L(0); PG8_BAR; PG8_MMA(0, 0, At, B0); PG8_MMA(0, 1, At, B1); PG8_BAR; PG8_SCHED;
            PG8_LDA(At, 0, 1); PG8_STAGE(PG8_SB(0, 0), b2, voffB); PG8_STAGE(PG8_SB(0, 1), b2 + hB, voffB); PG8_STAGE(PG8_SA(0, 0), a2, voffA);
            PG8_WAIT_V(8); PG8_WAIT_L(0); PG8_BAR; PG8_MMA(1, 0, At, B0); PG8_MMA(1, 1, At, B1); PG8_BAR; PG8_SCHED;
            PG8_LDB(B0, 1, 0); PG8_LDB(B1, 1, 1); PG8_SCHED; PG8_LDA(At, 1, 0); PG8_STAGE(PG8_SA(0, 1), a2 + hA, voffA);
            PG8_WAIT_V(8); PG8_WAIT_L(0); PG8_BAR; PG8_MMA(0, 0, At, B0); PG8_MMA(0, 1, At, B1); PG8_BAR; PG8_SCHED;
            PG8_LDA(At, 1, 1); PG8_STAGE(PG8_SB(1, 0), b3, voffB); PG8_STAGE(PG8_SB(1, 1), b3 + hB, voffB); PG8_STAGE(PG8_SA(1, 0), a3, voffA);
            PG8_WAIT_V(8); PG8_WAIT_L(0); PG8_BAR; PG8_MMA(1, 0, At, B0); PG8_MMA(1, 1, At, B1); PG8_BAR; PG8_SCHED;
        }
        if constexpr (ALIGN_EPI) { if (wr == 0) PG8_BAR; }
        E(acc, cur, wr, wc, fr, fq); S.done(cur);
        if (!has_next) break;
#pragma unroll
        for (int a = 0; a < 2; ++a)
#pragma unroll
            for (int b = 0; b < 2; ++b)
#pragma unroll
                for (int m = 0; m < 4; ++m)
#pragma unroll
                    for (int n = 0; n < 2; ++n) acc[a][b][m][n] = (f32x4){0.f, 0.f, 0.f, 0.f};
        cur = nxt; cA = nA; cB = nB; ++ui;
        if constexpr (ALIGN_EPI) { if (wr == 1) PG8_BAR; }
    }
    PG8_WAIT_V(0);
    if constexpr (!ALIGN_EPI) { if (wr == 0) PG8_BAR; }
    PG8_BAR;
#undef PG8_SA
#undef PG8_SB
#undef PG8_STAGE
#undef PG8_LDA
#undef PG8_LDB
#undef PG8_MMA
#undef PG8_WAIT_V
#undef PG8_WAIT_L
#undef PG8_BAR
#undef PG8_SCHED
}
}

namespace att {
constexpr int KVBLK = 64, QBLK = 32, DV = 128;
constexpr int SHM_V = KVBLK * DV * 2;
constexpr float THR2 = 11.5f;
constexpr float MASKV = -3.0e30f;
#define SBAR() __builtin_amdgcn_sched_barrier(0)
__device__ __forceinline__ int crow(int r, int hi) { return (r & 3) + 8 * (r >> 2) + 4 * hi; }
template <int DQK> __device__ __forceinline__ int kswz(int row, int colB) {
    if constexpr (DQK == 128) return row * 256 + (colB ^ ((row & 7) << 4));
    else return row * 384 + (colB ^ (((row >> 1) & 7) << 4));
}
__device__ __forceinline__ int v_st(int k, int c) { const int kk = (k & ~0xC) | ((k & 4) << 1) | ((k & 8) >> 1); return ((kk >> 3) * 4 + (c >> 5)) * 512 + ((kk & 7) * 32 + (c & 31)) * 2; }
__device__ __forceinline__ int v_rd_base(int lane) { return ((lane & 3) << 3) | (((lane >> 2) & 3) << 6) | (((lane >> 4) & 1) << 5) | (((lane >> 5) & 1) << 8); }
constexpr int v_rd_off(int d0, int ks, int half) { return d0 * 512 + ks * 4096 + half * 2048; }
template <int OFF> __device__ __forceinline__ s16x4 tr_read(int vb) {
    s16x4 r; asm volatile("ds_read_b64_tr_b16 %0, %1 offset:%2" : "=&v"(r) : "v"(vb), "i"(OFF) : "memory"); return r;
}
template <int D0> __device__ __forceinline__ void pv_one(f32x16& od, int vb, bf16x8 pa0, bf16x8 pa1, bf16x8 pa2, bf16x8 pa3) {
    const s16x4 l0 = tr_read<v_rd_off(D0, 0, 0)>(vb), h0 = tr_read<v_rd_off(D0, 0, 1)>(vb), l1 = tr_read<v_rd_off(D0, 1, 0)>(vb), h1 = tr_read<v_rd_off(D0, 1, 1)>(vb);
    const s16x4 l2 = tr_read<v_rd_off(D0, 2, 0)>(vb), h2 = tr_read<v_rd_off(D0, 2, 1)>(vb), l3 = tr_read<v_rd_off(D0, 3, 0)>(vb), h3 = tr_read<v_rd_off(D0, 3, 1)>(vb);
    asm volatile("s_waitcnt lgkmcnt(0)" ::: "memory"); SBAR();
#define PK(L, H) (bf16x8){L[0], L[1], L[2], L[3], H[0], H[1], H[2], H[3]}
    od = __builtin_amdgcn_mfma_f32_32x32x16_bf16(pa0, PK(l0, h0), od, 0, 0, 0);
    od = __builtin_amdgcn_mfma_f32_32x32x16_bf16(pa1, PK(l1, h1), od, 0, 0, 0);
    od = __builtin_amdgcn_mfma_f32_32x32x16_bf16(pa2, PK(l2, h2), od, 0, 0, 0);
    od = __builtin_amdgcn_mfma_f32_32x32x16_bf16(pa3, PK(l3, h3), od, 0, 0, 0);
#undef PK
}
__device__ __forceinline__ void pv_d0(f32x16* o, int vb, bf16x8 pa0, bf16x8 pa1, bf16x8 pa2, bf16x8 pa3) {
    pv_one<0>(o[0], vb, pa0, pa1, pa2, pa3); pv_one<1>(o[1], vb, pa0, pa1, pa2, pa3); pv_one<2>(o[2], vb, pa0, pa1, pa2, pa3); pv_one<3>(o[3], vb, pa0, pa1, pa2, pa3);
}
__device__ __forceinline__ void partialSM(f32x16& p0, f32x16& p1, float& m_reg, float& mn, float& alpha) {
    float pmax = p0[0];
#pragma unroll
    for (int r = 1; r < 16; ++r) pmax = fmaxf(pmax, p0[r]);
#pragma unroll
    for (int r = 0; r < 16; ++r) pmax = fmaxf(pmax, p1[r]);
    { auto rr = __builtin_amdgcn_permlane32_swap(__float_as_uint(pmax), __float_as_uint(pmax), false, false);
      pmax = fmaxf(__uint_as_float(rr[0]), __uint_as_float(rr[1])); }
    if (__builtin_expect(__all(pmax - m_reg <= THR2), 1)) { mn = m_reg; alpha = 1.f; }
    else { mn = fmaxf(m_reg, pmax); alpha = __builtin_amdgcn_exp2f(m_reg - mn); m_reg = mn; }
#pragma unroll
    for (int r = 0; r < 16; ++r) p0[r] = p0[r] - mn;
#pragma unroll
    for (int r = 0; r < 16; ++r) p1[r] = p1[r] - mn;
#pragma unroll
    for (int r = 0; r < 16; ++r) p0[r] = __builtin_amdgcn_exp2f(p0[r]);
}
__device__ __forceinline__ void finishSM(f32x16& p0, f32x16& p1, float alpha, float& l_reg, bf16x8& pa0, bf16x8& pa1, bf16x8& pa2, bf16x8& pa3) {
#pragma unroll
    for (int r = 0; r < 16; ++r) p1[r] = __builtin_amdgcn_exp2f(p1[r]);
    float ps = 0;
#pragma unroll
    for (int r = 0; r < 16; ++r) ps += p0[r];
#pragma unroll
    for (int r = 0; r < 16; ++r) ps += p1[r];
    { auto rr = __builtin_amdgcn_permlane32_swap(__float_as_uint(ps), __float_as_uint(ps), false, false);
      ps = __uint_as_float(rr[0]) + __uint_as_float(rr[1]); }
    l_reg = l_reg * alpha + ps;
#define PK4(P, BASE, OUT) do { unsigned a0 = cvt_pk_bf16(P[BASE + 0], P[BASE + 1]), a1 = cvt_pk_bf16(P[BASE + 2], P[BASE + 3]);   \
    unsigned b0 = cvt_pk_bf16(P[BASE + 4], P[BASE + 5]), b1 = cvt_pk_bf16(P[BASE + 6], P[BASE + 7]);                              \
    auto r0 = __builtin_amdgcn_permlane32_swap(a0, b0, false, false); auto r1 = __builtin_amdgcn_permlane32_swap(a1, b1, false, false); \
    u32x4 w = {r0[0], r1[0], r0[1], r1[1]}; OUT = __builtin_bit_cast(bf16x8, w); } while (0)
    PK4(p0, 0, pa0); PK4(p0, 8, pa1); PK4(p1, 0, pa2); PK4(p1, 8, pa3);
#undef PK4
}
template <int DQK, int QREG> __device__ __forceinline__ void qkt(f32x16& p0, f32x16& p1, LAS const char* Ks, const bf16x8* qr, LAS const char* ql, int r32, int hi) {
    p0 = f32x16{}; p1 = f32x16{};
#pragma unroll
    for (int d0 = 0; d0 < DQK / 16; ++d0) { const int cb = (d0 * 16 + hi * 8) * 2;
        const bf16x8 b0 = *(LAS const bf16x8*)(Ks + kswz<DQK>(r32, cb));
        const bf16x8 b1 = *(LAS const bf16x8*)(Ks + kswz<DQK>(32 + r32, cb));
        bf16x8 q; if (d0 < QREG) q = qr[d0 < QREG ? d0 : 0]; else q = *(LAS const bf16x8*)(ql + (d0 - QREG) * 1024);
        p0 = __builtin_amdgcn_mfma_f32_32x32x16_bf16(b0, q, p0, 0, 0, 0);
        p1 = __builtin_amdgcn_mfma_f32_32x32x16_bf16(b1, q, p1, 0, 0, 0); }
}
struct NaCtx { int KR0, rs, rw, qc, cst; LAS const float* bias; };
__device__ __forceinline__ void na_mask(f32x16& p0, f32x16& p1, const NaCtx& c, int t, int hi) {
    const int krl = c.KR0 + t; const bool rowok = (krl >= c.rs) && (krl < c.rs + 8);
    if (!rowok) {
#pragma unroll
        for (int r = 0; r < 16; ++r) { p0[r] = MASKV; p1[r] = MASKV; }
    } else {
        LAS const float* brow = c.bias + (krl - c.rw + 7) * 32 + 15 - c.qc;
#pragma unroll
        for (int r = 0; r < 16; ++r) {
            const int k0 = crow(r, hi), k1 = k0 + 32;
            const bool ok0 = (unsigned)(k0 - c.cst) < 16u, ok1 = (unsigned)(k1 - c.cst) < 16u;
            const float b0 = ok0 ? brow[k0] : 0.f, b1 = ok1 ? brow[k1] : 0.f;
            p0[r] = ok0 ? p0[r] + b0 : MASKV; p1[r] = ok1 ? p1[r] + b1 : MASKV;
            if ((r & 3) == 3) asm volatile("" ::: "memory");
        }
    }
}

template <int DQK, int MODE, int QREG>
__device__ __forceinline__ void attn_unit(const gbf16* __restrict__ Qb, int ldq, const gbf16* __restrict__ Kb, int ldk, const gbf16* __restrict__ Kpe,
                                          const gbf16* __restrict__ Vb, int ldv, gbf16* __restrict__ Ob, int ldo, int NT, LAS char* lds, NaCtx nc) {
    constexpr int SHM_K = KVBLK * DQK * 2;
    const int tid = threadIdx.x, wid = __builtin_amdgcn_readfirstlane(tid >> 6), lane = tid & 63, r32 = lane & 31, hi = lane >> 5;
#ifdef DBG_NO_ATT
    for (int i = tid; i < 256 * 16; i += 512) { const int r = i >> 4, c = (i & 15) * 8; *(GAS bf16x8*)(Ob + (size_t)r * ldo + c) = *(const GAS bf16x8*)(Qb + (size_t)r * ldq + c); }
    return;
#endif
    LAS char* V_lds = lds; LAS char* K_lds = lds + 2 * SHM_V;
    LAS float* ws = (LAS float*)(lds + 2 * SHM_V + 2 * SHM_K) + wid * 64; LAS float* li_l = ws; LAS float* al_l = ws + 32;
    constexpr int QL = DQK / 16 - QREG;
    LAS char* ql = lds + 2 * SHM_V + 2 * SHM_K + 2048 + wid * (QL * 1024) + lane * 16;
    float m_reg = -1e30f, l_reg = 0; f32x16 o[4] = {}; bf16x8 qr[QREG];
    const gbf16* Qw = Qb + (size_t)(wid * QBLK + r32) * ldq + hi * 8;
#pragma unroll
    for (int d0 = 0; d0 < QREG; ++d0) qr[d0] = *(const GAS bf16x8*)(Qw + d0 * 16);
#pragma unroll
    for (int d0 = QREG; d0 < DQK / 16; ++d0) *(LAS bf16x8*)(ql + (d0 - QREG) * 1024) = *(const GAS bf16x8*)(Qw + d0 * 16);
    const int sr = tid >> 4, sc = (tid & 15) * 8, vst0 = v_st(sr, sc), vst1 = v_st(32 + sr, sc);
    const int pr = tid >> 3, pc = (tid & 7) * 8;
    const int vb0 = (int)(unsigned)(uintptr_t)V_lds + v_rd_base(lane);
    bf16x8 vs0, vs1, ks0, ks1, kp0;
#define KEY0(t) ((MODE == 1 ? ((nc.KR0 + (t)) > 31 ? 31 : (nc.KR0 + (t))) : (t)) * KVBLK)
#define SLOAD(t) do { const int k0_ = KEY0(t); vs0 = *(const GAS bf16x8*)(Vb + (size_t)(k0_ + sr) * ldv + sc); vs1 = *(const GAS bf16x8*)(Vb + (size_t)(k0_ + 32 + sr) * ldv + sc); \
    ks0 = *(const GAS bf16x8*)(Kb + (size_t)(k0_ + sr) * ldk + sc); ks1 = *(const GAS bf16x8*)(Kb + (size_t)(k0_ + 32 + sr) * ldk + sc); \
    if constexpr (DQK == 192) kp0 = *(const GAS bf16x8*)(Kpe + (size_t)(k0_ + pr) * 64 + pc); } while (0)
#define SWRITE(b) do { *(LAS bf16x8*)(V_lds + (b) * SHM_V + vst0) = vs0; *(LAS bf16x8*)(V_lds + (b) * SHM_V + vst1) = vs1; \
    *(LAS bf16x8*)(K_lds + (b) * SHM_K + kswz<DQK>(sr, sc * 2)) = ks0; *(LAS bf16x8*)(K_lds + (b) * SHM_K + kswz<DQK>(32 + sr, sc * 2)) = ks1; \
    if constexpr (DQK == 192) *(LAS bf16x8*)(K_lds + (b) * SHM_K + kswz<DQK>(pr, 256 + pc * 2)) = kp0; } while (0)
#define RESC(a) do { if (__any((a) < 1.f)) { if (hi == 0) al_l[r32] = (a); asm volatile("s_waitcnt lgkmcnt(0)" ::: "memory"); \
    _Pragma("unroll") for (int d = 0; d < 4; ++d) _Pragma("unroll") for (int r = 0; r < 16; ++r) o[d][r] *= al_l[crow(r, hi)]; } } while (0)
    f32x16 pA0, pA1, pB0, pB1; float mnA, mnB, alA, alB; bf16x8 pa0, pa1, pa2, pa3;
    SLOAD(0); VM_WAIT(); SWRITE(0); __syncthreads();
    qkt<DQK, QREG>(pA0, pA1, K_lds, qr, ql, r32, hi); if constexpr (MODE == 1) na_mask(pA0, pA1, nc, 0, hi); partialSM(pA0, pA1, m_reg, mnA, alA);
    SLOAD(1); VM_WAIT(); SWRITE(1); __syncthreads();
    for (int j = 1; j + 1 < NT; j += 2) {
        SBAR(); qkt<DQK, QREG>(pB0, pB1, K_lds + SHM_K, qr, ql, r32, hi); if constexpr (MODE == 1) na_mask(pB0, pB1, nc, j, hi);
        finishSM(pA0, pA1, alA, l_reg, pa0, pa1, pa2, pa3); SBAR();
        SLOAD(j + 1); SBAR();
        pv_d0(o, vb0, pa0, pa1, pa2, pa3); partialSM(pB0, pB1, m_reg, mnB, alB);
        __syncthreads(); VM_WAIT(); SWRITE(0);
        RESC(alB); __syncthreads();
        SBAR(); qkt<DQK, QREG>(pA0, pA1, K_lds, qr, ql, r32, hi); if constexpr (MODE == 1) na_mask(pA0, pA1, nc, j + 1, hi);
        finishSM(pB0, pB1, alB, l_reg, pa0, pa1, pa2, pa3); SBAR();
        if (j + 2 < NT) SLOAD(j + 2); SBAR();
        pv_d0(o, vb0 + SHM_V, pa0, pa1, pa2, pa3); partialSM(pA0, pA1, m_reg, mnA, alA);
        __syncthreads(); VM_WAIT(); SWRITE(1);
        RESC(alA); __syncthreads();
    }
    SBAR(); qkt<DQK, QREG>(pB0, pB1, K_lds + SHM_K, qr, ql, r32, hi); if constexpr (MODE == 1) na_mask(pB0, pB1, nc, NT - 1, hi);
    finishSM(pA0, pA1, alA, l_reg, pa0, pa1, pa2, pa3); SBAR();
    pv_d0(o, vb0, pa0, pa1, pa2, pa3); partialSM(pB0, pB1, m_reg, mnB, alB);
    RESC(alB);
    finishSM(pB0, pB1, alB, l_reg, pa0, pa1, pa2, pa3); SBAR();
    pv_d0(o, vb0 + SHM_V, pa0, pa1, pa2, pa3);
    if (hi == 0) li_l[r32] = l_reg; asm volatile("s_waitcnt lgkmcnt(0)" ::: "memory");
    float rli[16];
#pragma unroll
    for (int r = 0; r < 16; ++r) rli[r] = __builtin_amdgcn_rcpf(li_l[crow(r, hi)]);
    gbf16* Ow = Ob + (size_t)(wid * QBLK) * ldo;
#pragma unroll
    for (int r = 0; r < 16; ++r) { const int orow = crow(r, hi);
#pragma unroll
        for (int d0 = 0; d0 < 4; ++d0) Ow[(size_t)orow * ldo + d0 * 32 + r32] = (bf16_t)(cvt_pk_bf16(o[d0][r] * rli[r], 0.f) & 0xffffu); }
    __syncthreads();
#undef KEY0
#undef SLOAD
#undef SWRITE
#undef RESC
}
}

#define XB_TMO      128
#define XB_XCNT(j)  (256  + 64 * (j))
#define XB_XSUB(j)  (1280 + 64 * (j))
#define XB_XGEN(j)  (2304 + 64 * (j))
#define XB_TOP      3328
#define XB_TOPGEN   3392
#define XCD_BAR_WORDS 3456
#define XB_SPIN_CAP (1u << 18)
__device__ __forceinline__ unsigned xb_ld(unsigned* p)              { return __hip_atomic_load(p, __ATOMIC_RELAXED, __HIP_MEMORY_SCOPE_AGENT); }
__device__ __forceinline__ unsigned xb_add(unsigned* p, unsigned v) { return __hip_atomic_fetch_add(p, v, __ATOMIC_RELAXED, __HIP_MEMORY_SCOPE_AGENT); }
__device__ __forceinline__ unsigned xb_xcc_id() { return (unsigned)__builtin_amdgcn_s_getreg((3 << 11) | 20) & 0xFu; }
#define XB_SPIN(cond, bar) do { unsigned _sp = 0; while (cond) { __builtin_amdgcn_s_sleep(1); \
    if ((++_sp & 255u) == 0u) { if (xb_ld(&(bar)[XB_TMO])) break; if (_sp > XB_SPIN_CAP) { atomicAdd(&(bar)[XB_TMO], 1u); break; } } } } while (0)
struct XcdBarrier { unsigned* bar; unsigned x; volatile LAS unsigned* st; };
__device__ __forceinline__ XcdBarrier xcd_barrier_post(unsigned* bar, volatile LAS unsigned* st) {
    XcdBarrier b; b.bar = bar; b.x = xb_xcc_id(); b.st = st;
    if (threadIdx.x == 0) (void)xb_add(&bar[XB_XCNT(b.x)], 1u);
    return b;
}
__device__ __forceinline__ void xcd_barrier_complete(unsigned* bar, unsigned x, unsigned& nloc, unsigned& nx) {
    const unsigned G = gridDim.x * gridDim.y * gridDim.z;
    unsigned sum, cnt, mine, sp = 0u;
    for (;;) {
        sum = 0u; cnt = 0u; mine = 0u;
#pragma unroll
        for (unsigned j = 0; j < 16; ++j) { const unsigned c = xb_ld(&bar[XB_XCNT(j)]); sum += c; cnt += (c > 0u) ? 1u : 0u; mine = (j == x) ? c : mine; }
        if (sum == G) break;
        __builtin_amdgcn_s_sleep(1);
        if ((++sp & 255u) == 0u) { if (xb_ld(&bar[XB_TMO])) break; if (sp > XB_SPIN_CAP) { atomicAdd(&bar[XB_TMO], 1u); break; } }
    }
    nloc = mine > 0u ? mine : 1u; nx = cnt > 0u ? cnt : 1u;
}
__device__ __forceinline__ void xcd_barrier(const XcdBarrier& b) {
    asm volatile("s_waitcnt vmcnt(0)" ::: "memory");
    __syncthreads();
    if (threadIdx.x == 0) {
        unsigned* bar = b.bar;
        __builtin_amdgcn_s_waitcnt(0);
        unsigned nloc = b.st[0], nx = b.st[1];
        if (nloc == 0u) { xcd_barrier_complete(bar, b.x, nloc, nx); b.st[0] = nloc; b.st[1] = nx; }
        const unsigned old = xb_add(&bar[XB_XSUB(b.x)], 1u);
        const unsigned gen = old / nloc;
        if (old + 1u == (gen + 1u) * nloc) {
            __builtin_amdgcn_fence(__ATOMIC_RELEASE, "agent");
            asm volatile("s_waitcnt vmcnt(0)" ::: "memory");
            const unsigned og = xb_add(&bar[XB_TOP], 1u);
            const unsigned tg = og / nx;
            if (og + 1u == (tg + 1u) * nx) xb_add(&bar[XB_TOPGEN], 1u);
            else XB_SPIN(xb_ld(&bar[XB_TOPGEN]) == tg, bar);
            __builtin_amdgcn_fence(__ATOMIC_ACQUIRE, "agent");
            xb_add(&bar[XB_XGEN(b.x)], 1u);
            asm volatile("s_waitcnt vmcnt(0)" ::: "memory");
        } else {
            XB_SPIN(xb_ld(&bar[XB_XGEN(b.x)]) == gen, bar);
            __builtin_amdgcn_fence(__ATOMIC_ACQUIRE, "agent");
            asm volatile("s_waitcnt vmcnt(0)" ::: "memory");
        }
    }
    __syncthreads();
}

template <int MODE> __device__ __forceinline__ int rowmap(int n, int row_off) {
    if constexpr (MODE == 0) return row_off + n;
    else if constexpr (MODE == 1) return ((n >> 7) << 8) + row_off + (n & 127);
    else if constexpr (MODE == 2) { const int h = n / MLA_QD, j = n - h * MLA_QD; if (j < 128) return n; const int i = j - 128; return h * MLA_QD + 128 + 2 * (i & 31) + (i >> 5); }
    else { if (n < INW - ROPED) return n; const int i = n - (INW - ROPED); return (INW - ROPED) + 2 * (i & 31) + (i >> 5); }
}
template <int MODE> __device__ __forceinline__ void tr_item(const gf32* __restrict__ W, int N, gbf16* __restrict__ WT, int ldt, int row_off, const gf32* __restrict__ gk, LAS unsigned* T, int item, int lane) {
    const int nblk = N >> 6, kb = item / nblk, nb = item - kb * nblk, k0 = kb << 6, n0 = nb << 6;
    const int l16 = lane & 15, kq = lane >> 4;
#pragma unroll
    for (int it = 0; it < 8; ++it) {
        const int kp = kq + 4 * it;
        const gf32* src = W + (size_t)(k0 + 2 * kp) * N + n0 + 4 * l16;
        f32x4 a = *(const GAS f32x4*)src, b = *(const GAS f32x4*)(src + N);
        if (gk) { const float g0 = gk[k0 + 2 * kp], g1 = gk[k0 + 2 * kp + 1]; a = a * g0; b = b * g1; }
        LAS unsigned* t = T + (4 * l16) * 33 + kp;
        t[0] = cvt_pk_bf16(a[0], b[0]); t[33] = cvt_pk_bf16(a[1], b[1]); t[66] = cvt_pk_bf16(a[2], b[2]); t[99] = cvt_pk_bf16(a[3], b[3]);
    }
    LDS_WAIT(); asm volatile("" ::: "memory");
    const int c = lane & 7;
#pragma unroll
    for (int j = 0; j < 8; ++j) { const int n = (lane >> 3) + 8 * j; LAS const unsigned* s = T + n * 33 + 4 * c;
        u32x4 o; o.x = s[0]; o.y = s[1]; o.z = s[2]; o.w = s[3];
        *(GAS u32x4*)(WT + (size_t)rowmap<MODE>(n0 + n, row_off) * ldt + k0 + 8 * c) = o; }
    LDS_WAIT(); asm volatile("" ::: "memory");
}
#define RSRC(p, bytes) __builtin_amdgcn_make_buffer_rsrc((void*)(p), 0, (int)(bytes), 0x00020000)
__device__ __forceinline__ f32x4 bld16(__amdgpu_buffer_rsrc_t r, int voff, int soff) { return __builtin_bit_cast(f32x4, __builtin_amdgcn_raw_buffer_load_b128(r, voff, soff, 0)); }
__device__ __forceinline__ u32x2 bld8(__amdgpu_buffer_rsrc_t r, int voff, int soff) { return __builtin_bit_cast(u32x2, __builtin_amdgcn_raw_buffer_load_b64(r, voff, soff, 0)); }
__device__ __forceinline__ void bst16(f32x4 v, __amdgpu_buffer_rsrc_t r, int voff, int soff) { __builtin_amdgcn_raw_buffer_store_b128(__builtin_bit_cast(u32x4, v), r, voff, soff, 0); }
__device__ __forceinline__ void bst8(u32x2 v, __amdgpu_buffer_rsrc_t r, int voff, int soff) { __builtin_amdgcn_raw_buffer_store_b64(v, r, voff, soff, 0); }
__device__ __forceinline__ void rms_rows_to_bf16(const gf32* x, const gf32* g, gbf16* o, int nrows, int gw, int NGW, int lane) {
    const __amdgpu_buffer_rsrc_t rx = RSRC(x, (size_t)nrows * D * 4), rg = RSRC(g, D * 4), ro = RSRC(o, (size_t)nrows * D * 2);
    const int l16 = lane * 16;
    for (int row = gw; row < nrows; row += NGW) {
        const int o16 = row * (D * 4) + lane * 16, o8 = row * (D * 2) + lane * 8;
        f32x4 v[16]; float s = 0.f;
#pragma unroll
        for (int j = 0; j < 16; ++j) { v[j] = bld16(rx, o16, j * 1024); s += (v[j][0] * v[j][0] + v[j][1] * v[j][1]) + (v[j][2] * v[j][2] + v[j][3] * v[j][3]); }
        const float rstd = rsqrtf(wave_sum(s) * (1.f / D) + EPS);
#pragma unroll
        for (int j = 0; j < 16; ++j) { const f32x4 gg = bld16(rg, l16, j * 1024); u32x2 w; w.x = cvt_pk_bf16(v[j][0] * rstd * gg[0], v[j][1] * rstd * gg[1]); w.y = cvt_pk_bf16(v[j][2] * rstd * gg[2], v[j][3] * rstd * gg[3]); bst8(w, ro, o8, j * 512);
            if ((j & 3) == 3) asm volatile("" ::: "memory"); }
    }
}
template <bool FINAL> __device__ __forceinline__ void row_phase(const gf32* hin, const gbf16* F, const gf32* SS, const gf32* gpost, float w,
                                                                const gf32* gnext, gf32* hout, gbf16* xn, int gw, int NGW, int lane) {
    const int l16 = lane * 16;
    const __amdgpu_buffer_rsrc_t rgp = RSRC(gpost, D * 4), rgn = RSRC(gnext, D * 4);
    const __amdgpu_buffer_rsrc_t rh = RSRC(hin, (size_t)M * D * 4), rf_ = RSRC(F, (size_t)M * D * 2), ro = RSRC(hout, (size_t)M * D * 4), rx = RSRC(FINAL ? (const void*)hout : (const void*)xn, (size_t)M * D * 2);
    for (int row = gw; row < M; row += NGW) {
        const int o16 = row * (D * 4) + lane * 16, o8 = row * (D * 2) + lane * 8;
        #ifdef DBG_NOSS
        const float rf = w;
#else
        const float rf = rsqrtf(wave_sum(SS[(size_t)row * 64 + lane]) * (1.f / D) + EPS) * w;
#endif
        f32x4 v[16]; float s = 0.f;
#pragma unroll
        for (int j = 0; j < 16; ++j) { const f32x4 h4 = bld16(rh, o16, j * 1024);
#ifdef DBG_NOF
            const u32x2 f2 = *(const GAS u32x2*)((const GAS char*)F + (size_t)row * (D * 2) + (unsigned)(lane * 8 + j * 512));
#else
            const u32x2 f2 = bld8(rf_, o8, j * 512);
#endif
            const f32x4 g4 = bld16(rgp, l16, j * 1024);
#ifdef DBG_VMW
            asm volatile("s_waitcnt vmcnt(0)" ::: "memory");
#endif
            v[j][0] = h4[0] + bf_lo(f2.x) * rf * g4[0]; v[j][1] = h4[1] + bf_hi(f2.x) * rf * g4[1]; v[j][2] = h4[2] + bf_lo(f2.y) * rf * g4[2]; v[j][3] = h4[3] + bf_hi(f2.y) * rf * g4[3];
#ifdef DBG_COPYF
            v[j][0] = bf_lo(f2.x); v[j][1] = bf_hi(f2.x); v[j][2] = bf_lo(f2.y); v[j][3] = bf_hi(f2.y);
#endif
            s += (v[j][0] * v[j][0] + v[j][1] * v[j][1]) + (v[j][2] * v[j][2] + v[j][3] * v[j][3]);
            if ((j & 3) == 3) asm volatile("" ::: "memory"); }
        const float rstd = rsqrtf(wave_sum(s) * (1.f / D) + EPS);
        if constexpr (FINAL) {
#pragma unroll
            for (int j = 0; j < 16; ++j) { const f32x4 g4 = bld16(rgn, l16, j * 1024); bst16(v[j] * rstd * g4, ro, o16 + j * 1024, 0); if ((j & 3) == 3) asm volatile("" ::: "memory"); } }
        else {
#pragma unroll
            for (int j = 0; j < 16; ++j) { const f32x4 g4 = bld16(rgn, l16, j * 1024);
                bst16(v[j], ro, o16 + j * 1024, 0); u32x2 wv; wv.x = cvt_pk_bf16(v[j][0] * rstd * g4[0], v[j][1] * rstd * g4[1]); wv.y = cvt_pk_bf16(v[j][2] * rstd * g4[2], v[j][3] * rstd * g4[3]); bst8(wv, rx, o8, j * 512);
                if ((j & 3) == 3) asm volatile("" ::: "memory"); } }
    }
}

constexpr int N_PHASES = 16;
struct Args { const void* in[25]; float* out; unsigned char* ws; int ph_lo, ph_hi; };
static_assert(sizeof(Args) == 25 * 8 + 8 + 8 + 8, "Args has no padding");

__global__ void __launch_bounds__(NTHREADS, 2) fwd(Args args) {
    extern __shared__ __attribute__((aligned(16))) unsigned char lds_raw[];
    LAS unsigned char* lds = (LAS unsigned char*)lds_raw;
    volatile LAS unsigned* MISC = (volatile LAS unsigned*)(lds + MISC_OFF);
    const int tid = threadIdx.x, lane = tid & 63, wave = __builtin_amdgcn_readfirstlane(tid >> 6);
    const int G = gridDim.x, bx = blockIdx.x, vcu = (G % 8 == 0) ? (bx % 8) * (G / 8) + bx / 8 : bx;
    const int gw = vcu * NWAVES + wave, NGW = G * NWAVES;
    unsigned char* ws = args.ws;
    unsigned* ctl = (unsigned*)(ws + WS_CTL);
    for (int u = tid; u < (LDS_BYTES - RING_BYTES) / 4; u += NTHREADS) ((LAS unsigned*)(lds + RING_BYTES))[u] = 0u;
    __syncthreads();
    XcdBarrier bar; bar.bar = ctl + CW_BAR; bar.x = 0; bar.st = nullptr;
    if (MK_N_LAUNCHES == 1) bar = xcd_barrier_post(ctl + CW_BAR, MISC + 8);
    const int lo = args.ph_lo, hi = args.ph_hi;
#ifndef PH_MASK
#define PH_MASK 0xFFFF
#endif
#define IN(k) ((((PH_MASK) >> (k)) & 1) && lo <= (k) && (k) < hi)
#define SEAM(k) do { if (IN(k) && IN((k) + 1)) xcd_barrier(bar); } while (0)

    if (tid < 25) { const unsigned long long p = (unsigned long long)args.in[tid]; MISC[16 + 2 * tid] = (unsigned)p; MISC[17 + 2 * tid] = (unsigned)(p >> 32); }
    if (tid == 25) { const unsigned long long p = (unsigned long long)args.out; MISC[16 + 50] = (unsigned)p; MISC[17 + 50] = (unsigned)(p >> 32); }
    if (tid == 26) { const unsigned long long p = (unsigned long long)args.ws; MISC[16 + 52] = (unsigned)p; MISC[17 + 52] = (unsigned)(p >> 32); }
    __syncthreads();
#define PTR(i) ((unsigned long long)(unsigned)__builtin_amdgcn_readfirstlane(MISC[16 + 2 * (i)]) | ((unsigned long long)(unsigned)__builtin_amdgcn_readfirstlane(MISC[17 + 2 * (i)]) << 32))
#define INF(i) ((const gf32*)PTR(i))
#define WSB ((gu8*)PTR(26))
#define WSP(T, off) ((T*)(WSB + (off)))

    if (IN(0)) {
        gu8* ws = WSB;
        LAS unsigned* T = (LAS unsigned*)(lds + wave * 16384);
        constexpr int I_GU = (D / 64) * (DFF / 64), I_DN = (DFF / 64) * (D / 64), I_IN = (D / 64) * (INW / 64), I_QB = (QRANK / 64) * (QBW / 64), I_KVB = (KVRANK / 64) * (KVBW / 64);
        constexpr int I_OUT = (D / 64) * (D / 64), I_MQ = (D / 64) * (MEMW / 64), I_MKV = (D / 64) * (2 * MEMW / 64), I_MO = (MEMW / 64) * (D / 64);
        constexpr int NITEMS = 4 * I_GU + 2 * I_DN + I_IN + I_QB + I_KVB + I_OUT + I_MQ + I_MKV + I_MO;
        for (int it = gw; it < NITEMS; it += NGW) {
            int r = it;
            if (r < I_GU) { tr_item<1>(INF(3), DFF, (gbf16*)(ws + WS_WGU1), D, 0, nullptr, T, r, lane); continue; } r -= I_GU;
            if (r < I_GU) { tr_item<1>(INF(4), DFF, (gbf16*)(ws + WS_WGU1), D, 128, nullptr, T, r, lane); continue; } r -= I_GU;
            if (r < I_DN) { tr_item<0>(INF(5), D, (gbf16*)(ws + WS_WD1), DFF, 0, nullptr, T, r, lane); continue; } r -= I_DN;
            if (r < I_IN) { tr_item<3>(INF(7), INW, (gbf16*)(ws + WS_WIN), D, 0, nullptr, T, r, lane); continue; } r -= I_IN;
            if (r < I_QB) { tr_item<2>(INF(9), QBW, (gbf16*)(ws + WS_WQB), QRANK, 0, INF(8), T, r, lane); continue; } r -= I_QB;
            if (r < I_KVB) { tr_item<0>(INF(11), KVBW, (gbf16*)(ws + WS_WKVB), KVRANK, 0, INF(10), T, r, lane); continue; } r -= I_KVB;
            if (r < I_OUT) { tr_item<0>(INF(13), D, (gbf16*)(ws + WS_WOUT), D, 0, nullptr, T, r, lane); continue; } r -= I_OUT;
            if (r < I_MQ) { tr_item<0>(INF(16), MEMW, (gbf16*)(ws + WS_WMQ), D, 0, nullptr, T, r, lane); continue; } r -= I_MQ;
            if (r < I_MKV) { tr_item<0>(INF(17), 2 * MEMW, (gbf16*)(ws + WS_WMKV), D, 0, nullptr, T, r, lane); continue; } r -= I_MKV;
            if (r < I_MO) { tr_item<0>(INF(18), D, (gbf16*)(ws + WS_WMO), MEMW, 0, nullptr, T, r, lane); continue; } r -= I_MO;
            if (r < I_GU) { tr_item<1>(INF(20), DFF, (gbf16*)(ws + WS_WGU2), D, 0, nullptr, T, r, lane); continue; } r -= I_GU;
            if (r < I_GU) { tr_item<1>(INF(21), DFF, (gbf16*)(ws + WS_WGU2), D, 128, nullptr, T, r, lane); continue; } r -= I_GU;
            tr_item<0>(INF(22), D, (gbf16*)(ws + WS_WD2), DFF, 0, nullptr, T, r, lane);
        }
        { GAS u32x4* z = (GAS u32x4*)((gbf16*)(ws + WS_WIN) + (size_t)INW * D); const int nz = (INWP - INW) * D * 2 / 16; for (int i = bx * NTHREADS + tid; i < nz; i += G * NTHREADS) z[i] = (u32x4){0u, 0u, 0u, 0u}; }
        { const GAS int* positions = (const GAS int*)PTR(2); GAS f32x2* ROPE = (GAS f32x2*)(ws + WS_ROPE);
          for (int i = bx * NTHREADS + tid; i < M * 32; i += G * NTHREADS) { const int row = i >> 5, p = i & 31;
            double f = 1.0; for (int q = 0; q < p; ++q) f *= 0.74989420933245582730;
            const float ang = (float)positions[row] * (float)f;
            double rev = (double)ang * 0.15915494309189533577; rev -= __builtin_floor(rev);
            const float rv = (float)rev;
            ROPE[i] = (f32x2){__builtin_amdgcn_cosf(rv), __builtin_amdgcn_sinf(rv)}; } }
        { const gf32* x = INF(0); const gf32* g = INF(6); gbf16* XN = (gbf16*)(ws + WS_XN);
          rms_rows_to_bf16(x, g, XN, M, gw, NGW, lane); }
        { const gf32* mem = INF(1); const gf32* g = INF(15); gbf16* MEMN = (gbf16*)(ws + WS_MEMN);
          rms_rows_to_bf16(mem, g, MEMN, MEMROWS, gw, NGW, lane); }
    }
    SEAM(0);
    if (IN(1)) { gu8* ws = WSB; pg8::Gemm g{(gbf16*)(ws + WS_XN), (gbf16*)(ws + WS_WGU1), M, 2 * DFF, D, D, D}; pg8::StaticOrder S; S.init(M, 2 * DFF, G, bx); pg8::EpiSwiglu E{(gbf16*)(ws + WS_ACT), DFF}; pg8::gemm_phase(lds, g, S, E); }
    SEAM(1);
    if (IN(2)) { gu8* ws = WSB; pg8::Gemm g{(gbf16*)(ws + WS_ACT), (gbf16*)(ws + WS_WD1), M, D, DFF, DFF, DFF}; pg8::StaticOrder S; S.init(M, D, G, bx); pg8::EpiF E{(gbf16*)(ws + WS_F), D, (gf32*)(ws + WS_SS), 64, 1.0f}; pg8::gemm_phase(lds, g, S, E); }
    SEAM(2);
    if (IN(3)) {
#ifdef DBG_DELAY
        { const unsigned long long t0 = __builtin_amdgcn_s_memrealtime(); while (__builtin_amdgcn_s_memrealtime() - t0 < 50000ull) __builtin_amdgcn_s_sleep(8); }
#endif
#ifdef DBG_LINCOPY
        { gu8* ws = WSB; const gbf16* src = (const gbf16*)(ws + WS_F); gf32* o = (gf32*)(ws + WS_H); for (size_t i = (size_t)bx * NTHREADS + tid; i < (size_t)M * D; i += (size_t)G * NTHREADS) o[i] = __uint_as_float(((unsigned)src[i]) << 16); }
#else
        gu8* ws = WSB; row_phase<false>(INF(0), (gbf16*)(ws + WS_F), (gf32*)(ws + WS_SS), INF(6) + D, 0.5f, INF(14), (gf32*)(ws + WS_H), (gbf16*)(ws + WS_XN), gw, NGW, lane);
#endif
    }
    SEAM(3);
    if (IN(4)) { gu8* ws = WSB; pg8::Gemm g{(gbf16*)(ws + WS_XN), (gbf16*)(ws + WS_WIN), M, INWP, D, D, D}; pg8::StaticOrder S; S.init(M, INWP, G, bx);
        pg8::EpiInProj E{(gbf16*)(ws + WS_U), (gf32*)(ws + WS_SSQ), (gf32*)(ws + WS_SSQ) + (size_t)M * 16, (gbf16*)(ws + WS_KPE), (const GAS f32x2*)(ws + WS_ROPE), 0.08838834764831845f * LOG2E}; pg8::gemm_phase(lds, g, S, E); }
    SEAM(4);
    if (IN(5)) {
        { gu8* ws = WSB; pg8::Gemm g{(gbf16*)(ws + WS_U) + 3 * NAW, (gbf16*)(ws + WS_WQB), M, QBW, QRANK, INWP, QRANK}; pg8::StaticOrder S; S.init(M, QBW, G, bx);
          pg8::EpiQb E{(gbf16*)(ws + WS_QMLA), (gf32*)(ws + WS_SSQ), (const GAS f32x2*)(ws + WS_ROPE), 0.07216878364870323f * LOG2E}; pg8::gemm_phase(lds, g, S, E); }
        { gu8* ws = WSB; pg8::Gemm g{(gbf16*)(ws + WS_U) + 3 * NAW + QRANK, (gbf16*)(ws + WS_WKVB), M, KVBW, KVRANK, INWP, KVRANK}; pg8::StaticOrder S; S.init(M, KVBW, G, (bx + 128) % G);
          pg8::EpiKvb E{(gbf16*)(ws + WS_KVMLA), (gf32*)(ws + WS_SSQ) + (size_t)M * 16}; pg8::gemm_phase(lds, g, S, E); }
        { gu8* ws = WSB; const gf32* na_rpb = INF(12); const gbf16* U = (const gbf16*)(ws + WS_U); gbf16* OCAT = (gbf16*)(ws + WS_OCAT);
          LAS float* btab = (LAS float*)(lds + 106496);
          for (int un = vcu; un < BATCH * NHEAD * 8; un += G) {
            const int bh = un >> 3, rg = un & 7, b = bh >> 4, h = bh & 15;
            if (tid < 15 * 32) { const int dr = tid >> 5, dc = tid & 31; btab[tid] = dc < 31 ? na_rpb[(h * 15 + dr) * 31 + dc] * LOG2E : 0.f; }
            const int r0 = 4 * rg, KR0 = (r0 - 4 < 0 ? 0 : (r0 - 4 > 24 ? 24 : r0 - 4)), rl = r0 + 3, KR1 = (rl - 4 < 0 ? 0 : (rl - 4 > 24 ? 24 : rl - 4)) + 7;
            const int NT = (KR1 - KR0 + 2) & ~1;
            att::NaCtx nc; const int rw = r0 + (wave >> 1); nc.KR0 = KR0; nc.rw = rw; nc.rs = (rw - 4 < 0 ? 0 : (rw - 4 > 24 ? 24 : rw - 4));
            nc.qc = 32 * (wave & 1) + (lane & 31); nc.cst = (nc.qc - 8 < 0 ? 0 : (nc.qc - 8 > 48 ? 48 : nc.qc - 8)); nc.bias = btab;
            const size_t tok0 = (size_t)b * SEQ;
            att::attn_unit<128, 1, 4>(U + (tok0 + rg * 256) * INWP + h * 128, INWP, U + tok0 * INWP + NAW + h * 128, INWP, nullptr, U + tok0 * INWP + 2 * NAW + h * 128, INWP,
                                   OCAT + (tok0 + rg * 256) * D + h * 128, D, NT, (LAS char*)lds, nc);
          } }
    }
    SEAM(5);
    if (IN(6)) {
        gu8* ws = WSB; const gbf16* QMLA = (const gbf16*)(ws + WS_QMLA); const gbf16* KVMLA = (const gbf16*)(ws + WS_KVMLA); const gbf16* KPE = (const gbf16*)(ws + WS_KPE); gbf16* OCAT = (gbf16*)(ws + WS_OCAT);
        att::NaCtx nc{};
        for (int un = vcu; un < BATCH * NHEAD * 8; un += G) {
            const int bh = un >> 3, qb = un & 7, b = bh >> 4, h = bh & 15; const size_t tok0 = (size_t)b * SEQ;
            att::attn_unit<192, 0, 6>(QMLA + (tok0 + qb * 256) * QBW + h * MLA_QD, QBW, KVMLA + tok0 * KVBW + h * MLA_KVD, KVBW, KPE + tok0 * 64, KVMLA + tok0 * KVBW + h * MLA_KVD + 128, KVBW,
                                   OCAT + (tok0 + qb * 256) * D + NAW + h * 128, D, SEQ / 64, (LAS char*)lds, nc);
        }
    }
    SEAM(6);
    if (IN(7)) { gu8* ws = WSB; pg8::Gemm g{(gbf16*)(ws + WS_OCAT), (gbf16*)(ws + WS_WOUT), M, D, D, D, D}; pg8::StaticOrder S; S.init(M, D, G, bx); pg8::EpiF E{(gbf16*)(ws + WS_F), D, (gf32*)(ws + WS_SS), 64, 1.0f}; pg8::gemm_phase(lds, g, S, E); }
    SEAM(7);
    if (IN(8)) { gu8* ws = WSB; row_phase<false>((gf32*)(ws + WS_H), (gbf16*)(ws + WS_F), (gf32*)(ws + WS_SS), INF(14) + D, 1.0f, INF(19), (gf32*)(ws + WS_H), (gbf16*)(ws + WS_XN), gw, NGW, lane); }
    SEAM(8);
    if (IN(9)) {
        { gu8* ws = WSB; pg8::Gemm g{(gbf16*)(ws + WS_XN), (gbf16*)(ws + WS_WMQ), M, MEMW, D, D, D}; pg8::StaticOrder S; S.init(M, MEMW, G, bx); pg8::EpiF E{(gbf16*)(ws + WS_QM), MEMW, nullptr, 0, 0.08838834764831845f * LOG2E}; pg8::gemm_phase(lds, g, S, E); }
        { gu8* ws = WSB; pg8::Gemm g{(gbf16*)(ws + WS_MEMN), (gbf16*)(ws + WS_WMKV), MEMROWS, 2 * MEMW, D, D, D}; pg8::StaticOrder S; S.init(MEMROWS, 2 * MEMW, G, (bx + G - 64) % G); pg8::EpiF E{(gbf16*)(ws + WS_KVM), 2 * MEMW, nullptr, 0, 1.0f}; pg8::gemm_phase(lds, g, S, E); }
    }
    SEAM(9);
    if (IN(10)) {
        gu8* ws = WSB; const gbf16* QM = (const gbf16*)(ws + WS_QM); const gbf16* KVM = (const gbf16*)(ws + WS_KVM); gbf16* OM = (gbf16*)(ws + WS_OM);
        att::NaCtx nc{};
        for (int un = vcu; un < BATCH * 4 * 8; un += G) {
            const int b = un >> 5, h = (un >> 3) & 3, qb = un & 7;
            att::attn_unit<128, 0, 8>(QM + ((size_t)b * SEQ + qb * 256) * MEMW + h * 128, MEMW, KVM + (size_t)b * MEMLEN * 1024 + h * 256, 1024, nullptr, KVM + (size_t)b * MEMLEN * 1024 + h * 256 + 128, 1024,
                                   OM + ((size_t)b * SEQ + qb * 256) * MEMW + h * 128, MEMW, MEMLEN / 64, (LAS char*)lds, nc);
        }
    }
    SEAM(10);
    if (IN(11)) { gu8* ws = WSB; pg8::Gemm g{(gbf16*)(ws + WS_OM), (gbf16*)(ws + WS_WMO), M, D, MEMW, MEMW, MEMW}; pg8::StaticOrder S; S.init(M, D, G, bx); pg8::EpiF E{(gbf16*)(ws + WS_F), D, (gf32*)(ws + WS_SS), 64, 1.0f}; pg8::gemm_phase(lds, g, S, E); }
    SEAM(11);
    if (IN(12)) { gu8* ws = WSB; row_phase<false>((gf32*)(ws + WS_H), (gbf16*)(ws + WS_F), (gf32*)(ws + WS_SS), INF(19) + D, 1.0f, INF(23), (gf32*)(ws + WS_H), (gbf16*)(ws + WS_XN), gw, NGW, lane); }
    SEAM(12);
    if (IN(13)) { gu8* ws = WSB; pg8::Gemm g{(gbf16*)(ws + WS_XN), (gbf16*)(ws + WS_WGU2), M, 2 * DFF, D, D, D}; pg8::StaticOrder S; S.init(M, 2 * DFF, G, bx); pg8::EpiSwiglu E{(gbf16*)(ws + WS_ACT), DFF}; pg8::gemm_phase(lds, g, S, E); }
    SEAM(13);
    if (IN(14)) { gu8* ws = WSB; pg8::Gemm g{(gbf16*)(ws + WS_ACT), (gbf16*)(ws + WS_WD2), M, D, DFF, DFF, DFF}; pg8::StaticOrder S; S.init(M, D, G, bx); pg8::EpiF E{(gbf16*)(ws + WS_F), D, (gf32*)(ws + WS_SS), 64, 1.0f}; pg8::gemm_phase(lds, g, S, E); }
    SEAM(14);
    if (IN(15)) { gu8* ws = WSB; row_phase<true>((gf32*)(ws + WS_H), (gbf16*)(ws + WS_F), (gf32*)(ws + WS_SS), INF(23) + D, 0.5f, INF(24), (gf32*)PTR(25), nullptr, gw, NGW, lane); }
#ifdef DBG_DUMP
    if (lo == 16) { gu8* ws = WSB; gf32* o = (gf32*)PTR(25);
        if (DBG_DUMP_F32) { const gf32* src = (const gf32*)(ws + DBG_DUMP_OFF); for (size_t i = (size_t)bx * NTHREADS + tid; i < (size_t)M * D; i += (size_t)G * NTHREADS) o[i] = src[i]; }
        else if (DBG_DUMP_ROWPAT) { const gbf16* src = (const gbf16*)(ws + DBG_DUMP_OFF);
            for (int row = gw; row < M; row += NGW) for (int j = 0; j < 16; ++j) { const u32x2 f2 = *(const GAS u32x2*)((const GAS char*)src + (size_t)row * (D * 2) + (unsigned)(lane * 8 + j * 512));
                f32x4 v; v[0] = bf_lo(f2.x); v[1] = bf_hi(f2.x); v[2] = bf_lo(f2.y); v[3] = bf_hi(f2.y); *(GAS f32x4*)((GAS char*)o + (size_t)row * (D * 4) + (unsigned)(lane * 16 + j * 1024)) = v; } }
        else { const gbf16* src = (const gbf16*)(ws + DBG_DUMP_OFF); for (size_t i = (size_t)bx * NTHREADS + tid; i < (size_t)M * D; i += (size_t)G * NTHREADS) o[i] = __uint_as_float(((unsigned)src[i]) << 16); } }
#endif
#undef IN
#undef SEAM
}

extern "C" void kernel_launch(void* const* d_in, const int* in_sizes, int n_in, void* d_out, int out_size, void* d_ws, size_t ws_size, hipStream_t stream) {
    static int grid = 0;
    if (grid == 0) {
        if (n_in != 25 || out_size != M * D || ws_size < WS_END) { fprintf(stderr, "kernel_launch: unexpected shapes (n_in %d, out %d, ws %zu < %zu)\n", n_in, out_size, ws_size, (size_t)WS_END); grid = -1; return; }
        int dev = 0, cus = 0, per_cu = 0;
        if (hipGetDevice(&dev) != hipSuccess || hipDeviceGetAttribute(&cus, hipDeviceAttributeMultiprocessorCount, dev) != hipSuccess) { grid = -1; return; }
        if (hipFuncSetAttribute((const void*)fwd, hipFuncAttributeMaxDynamicSharedMemorySize, LDS_BYTES) != hipSuccess) { fprintf(stderr, "kernel_launch: hipFuncSetAttribute failed\n"); grid = -1; return; }
        if (hipOccupancyMaxActiveBlocksPerMultiprocessor(&per_cu, (const void*)fwd, NTHREADS, LDS_BYTES) != hipSuccess || per_cu < 1) { fprintf(stderr, "kernel_launch: occupancy query says %d blocks per CU\n", per_cu); (void)hipGetLastError(); }
        grid = cus;
    }
    if (grid < 0) return;
    (void)in_sizes;
    if (hipMemsetAsync((char*)d_ws + WS_CTL, 0, CTL_ZERO_BYTES, stream) != hipSuccess) return;
    Args a{};
    for (int i = 0; i < 25; ++i) a.in[i] = d_in[i];
    a.out = (float*)d_out; a.ws = (unsigned char*)d_ws;
    if (MK_N_LAUNCHES == 1) { a.ph_lo = 0; a.ph_hi = N_PHASES; hipLaunchKernelGGL(fwd, dim3(grid), dim3(NTHREADS), LDS_BYTES, stream, a); }
    else {
#ifdef DBG_DUMP
        for (int p = 0; p <= DBG_DUMP; ++p) { a.ph_lo = p; a.ph_hi = p + 1; hipLaunchKernelGGL(fwd, dim3(grid), dim3(NTHREADS), LDS_BYTES, stream, a); }
        a.ph_lo = 16; a.ph_hi = 17; hipLaunchKernelGGL(fwd, dim3(grid), dim3(NTHREADS), LDS_BYTES, stream, a);
#else
        for (int p = 0; p < N_PHASES; ++p) { a.ph_lo = p; a.ph_hi = p + 1; hipLaunchKernelGGL(fwd, dim3(grid), dim3(NTHREADS), LDS_BYTES, stream, a); }
#endif
    }
    const hipError_t le = hipPeekAtLastError();
    if (le != hipSuccess) fprintf(stderr, "kernel_launch: launch failed: %s\n", hipGetErrorName(le));
}
```

```cpp
#include <hip/hip_runtime.h>
#include <cstdio>
#include <cstdint>

#ifndef MK_N_LAUNCHES
#define MK_N_LAUNCHES 1
#endif

#define LAS __attribute__((address_space(3)))
#define GAS __attribute__((address_space(1)))
typedef unsigned short bf16_t;
typedef __attribute__((address_space(1))) unsigned short gbf16;
typedef __attribute__((address_space(1))) float gf32;
typedef __attribute__((address_space(1))) unsigned char gu8;
typedef short bf16x8 __attribute__((ext_vector_type(8)));
typedef short s16x4 __attribute__((ext_vector_type(4)));
typedef float f32x2 __attribute__((ext_vector_type(2)));
typedef float f32x4 __attribute__((ext_vector_type(4)));
typedef float f32x16 __attribute__((ext_vector_type(16)));
typedef unsigned u32x2 __attribute__((ext_vector_type(2)));
typedef unsigned u32x4 __attribute__((ext_vector_type(4)));
typedef int i32x4 __attribute__((ext_vector_type(4)));
typedef int i32x8 __attribute__((ext_vector_type(8)));

constexpr int D = 4096, BATCH = 4, SEQ = 2048, M = BATCH * SEQ, DFF = 11008;
constexpr int NAW = 2048, QRANK = 1024, KVRANK = 512, ROPED = 64, INW = 3 * NAW + QRANK + KVRANK + ROPED  , INWP = 7936  ;
constexpr int NHEAD = 16, MLA_QD = 192, MLA_KVD = 256, QBW = NHEAD * MLA_QD  , KVBW = NHEAD * MLA_KVD  ;
constexpr int MEMLEN = 256, MEMROWS = BATCH * MEMLEN, MEMW = 512;
constexpr float EPS = 1e-6f, LOG2E = 1.4426950408889634f;
constexpr int NWAVES = 8, NTHREADS = 512;

constexpr size_t MiB = 1u << 20;
constexpr size_t WS_CTL = 0, CTL_ZERO_BYTES = 448 * 1024;
constexpr size_t WS_SCW = WS_CTL + 128 * 1024;
constexpr size_t WS_WGU1 = 1 * MiB, WS_WD1 = WS_WGU1 + 172 * MiB, WS_WGU2 = WS_WD1 + 86 * MiB, WS_WD2 = WS_WGU2 + 172 * MiB, WS_WIN = WS_WD2 + 86 * MiB;
constexpr size_t WS_WQB = WS_WIN + 62 * MiB, WS_WKVB = WS_WQB + 6 * MiB, WS_WOUT = WS_WKVB + 4 * MiB, WS_WMQ = WS_WOUT + 32 * MiB, WS_WMKV = WS_WMQ + 4 * MiB, WS_WMO = WS_WMKV + 8 * MiB;
constexpr size_t WS_H = WS_WMO + 4 * MiB;
constexpr size_t WS_H8 = WS_H + 64 * MiB;
constexpr size_t WS_XN = WS_H + 128 * MiB;
constexpr size_t WS_ACT = WS_XN + 64 * MiB;
constexpr size_t WS_F = WS_ACT + 172 * MiB;
constexpr size_t WS_SS = WS_F + 64 * MiB;
constexpr size_t WS_SSQ = WS_SS + 2 * MiB;
constexpr size_t WS_KPE = WS_SSQ + 1 * MiB;
constexpr size_t WS_MEMN = WS_KPE + 1 * MiB;
constexpr size_t WS_KVM = WS_MEMN + 8 * MiB;
constexpr size_t WS_QM = WS_KVM + 2 * MiB;
constexpr size_t WS_OM = WS_QM + 8 * MiB;
constexpr size_t WS_ROPE = WS_OM + 8 * MiB;
constexpr size_t WS_END = WS_ROPE + 2 * MiB;
constexpr size_t WS_RS = WS_SSQ + 768 * 1024;
constexpr size_t WS_QP = WS_ACT;
constexpr size_t WS_SCW2 = WS_CTL + 256 * 1024;
constexpr int NQT0 = 23;
constexpr size_t WS_SCW3 = WS_CTL + 384 * 1024;
constexpr size_t WS_WINQ = WS_H + 96 * MiB;
constexpr float CLIPF = 1.45f;
constexpr size_t WS_ST1 = WS_WGU2, WS_ST2 = WS_WGU2 + 8 * MiB;
constexpr size_t WS_P1A = WS_WGU1, WS_P1B = WS_WGU2 + 16 * MiB;
constexpr size_t WS_WGU1Q = WS_H;
constexpr size_t WS_WGU2Q = WS_WGU1;
constexpr size_t WS_X8 = WS_F;
constexpr size_t WS_RSX = WS_SSQ + 800 * 1024;
constexpr size_t WS_U = WS_ACT, WS_QMLA = WS_ACT + 124 * MiB, WS_KVMLA = WS_F, WS_OCAT = WS_XN;
static_assert((size_t)22016 * 4096 * 2 == 172 * MiB && (size_t)4096 * 11008 * 2 == 86 * MiB && (size_t)INWP * 4096 * 2 == 62 * MiB && (size_t)M * INWP * 2 == 124 * MiB, "ws map");
constexpr int CW_BAR = 1024;

constexpr int RING_BYTES = 143360;
constexpr int MISC_OFF = RING_BYTES + 320;
constexpr int LDS_BYTES = 147456;

#define LDS_WAIT() asm volatile("s_waitcnt lgkmcnt(0)" ::: "memory")
#define VM_WAIT() asm volatile("s_waitcnt vmcnt(0)" ::: "memory")
__device__ __forceinline__ unsigned cvt_pk_bf16(float lo, float hi) { unsigned r; asm volatile("v_cvt_pk_bf16_f32 %0, %1, %2" : "=v"(r) : "v"(lo), "v"(hi)); return r; }
__device__ __forceinline__ float bf_lo(unsigned w) { return __uint_as_float(w << 16); }
__device__ __forceinline__ float bf_hi(unsigned w) { return __uint_as_float(w & 0xffff0000u); }
__device__ __forceinline__ int lane_id_fresh() { int l; asm volatile("v_mbcnt_lo_u32_b32 %0, -1, 0\n\tv_mbcnt_hi_u32_b32 %0, -1, %0" : "=v"(l)); return l; }
__device__ __forceinline__ float wave_sum(float v) {
#pragma unroll
    for (int o = 1; o < 64; o <<= 1) v += __shfl_xor(v, o);
    return v;
}

__device__ __forceinline__ float wave_max(float v) {
#pragma unroll
    for (int o = 1; o < 64; o <<= 1) v = fmaxf(v, __shfl_xor(v, o));
    return v;
}
__device__ __forceinline__ unsigned pack4_i8(const f32x4 v) {
    const float MG = 12582912.f;
    const unsigned a = __float_as_uint(__builtin_fminf(__builtin_fmaxf(v[0], -127.f), 127.f) + MG) & 0xffu, b = __float_as_uint(__builtin_fminf(__builtin_fmaxf(v[1], -127.f), 127.f) + MG) & 0xffu;
    const unsigned c = __float_as_uint(__builtin_fminf(__builtin_fmaxf(v[2], -127.f), 127.f) + MG) & 0xffu, d = __float_as_uint(__builtin_fminf(__builtin_fmaxf(v[3], -127.f), 127.f) + MG) << 24;
    return a | (b << 8) | (c << 16) | d;
}

namespace pg8 {
constexpr int BM = 256, BK = 64, HALF = 128, HTB = HALF * BK * 2, STAGE_BYTES = 8 * HTB, NXCD = 8, WGM = 8;
__host__ __device__ __forceinline__ int lds_byte(int r, int c) { const int st = (r >> 4) * 2 + (c >> 5), rr = r & 15, cc = c & 31, ob = rr * 64 + cc * 2; return st * 1024 + (ob ^ (((ob >> 9) & 1) << 5)); }
__host__ __device__ __forceinline__ void stage_rc(int b, int& R, int& C) { const int st = b / 1024, sb = b % 1024, swz = sb ^ (((sb >> 9) & 1) << 5); R = (st >> 1) * 16 + swz / 64; C = (st & 1) * 32 + (swz % 64) / 2; }
__host__ __device__ __forceinline__ int perm32(int rho) { const int n = rho >> 4, i = rho & 15; return 8 * (i >> 2) + 4 * n + (i & 3); }

struct Unit { int pm, pn; };
struct Gemm { const gbf16* A; const gbf16* Bt; int M, N, K, lda, ldb; };

struct StaticOrder {
    int nM, nN, nwg, G, c;
    __host__ __device__ void init(int M_, int N_, int G_, int c_) { nM = M_ / BM; nN = N_ / BM; nwg = nM * nN; G = G_; c = c_; }
    __host__ __device__ bool next(int i, Unit& u) const {
        const long L = (long)i * G + c; if (L >= nwg) return false;
        int wgid = (int)L; { const int q = nwg / NXCD, r = nwg % NXCD, xcd = wgid % NXCD, off = wgid / NXCD; wgid = (xcd < r ? xcd * (q + 1) : r * (q + 1) + (xcd - r) * q) + off; }
        const int nig = WGM * nN, gid = wgid / nig, fm = gid * WGM, gsz = (nM - fm) < WGM ? (nM - fm) : WGM;
        u.pm = fm + ((wgid % nig) % gsz); u.pn = (wgid % nig) / gsz; return true;
    }
    __device__ __forceinline__ void a_ready(const Unit&) const {}
    __device__ __forceinline__ void done(const Unit&) const {}
};

__device__ __forceinline__ u32x4 pack8(const f32x4 v0, const f32x4 v1) { u32x4 w; w.x = cvt_pk_bf16(v0[0], v0[1]); w.y = cvt_pk_bf16(v0[2], v0[3]); w.z = cvt_pk_bf16(v1[0], v1[1]); w.w = cvt_pk_bf16(v1[2], v1[3]); return w; }
__device__ __forceinline__ float sq8(const f32x4 a, const f32x4 b) { return (a[0] * a[0] + a[1] * a[1]) + (a[2] * a[2] + a[3] * a[3]) + (b[0] * b[0] + b[1] * b[1]) + (b[2] * b[2] + b[3] * b[3]); }
__device__ __forceinline__ float silu_f(float g) { return g * __builtin_amdgcn_rcpf(1.0f + __builtin_amdgcn_exp2f(-LOG2E * g)); }
__device__ __forceinline__ void rope8(f32x4& v0, f32x4& v1, const GAS f32x2* cs) {
    const f32x4 c01 = *(const GAS f32x4*)cs, c23 = *(const GAS f32x4*)(cs + 2);
    f32x4 o0, o1;
    o0[0] = v0[0] * c01[0] - v0[1] * c01[1]; o0[1] = v0[1] * c01[0] + v0[0] * c01[1];
    o0[2] = v0[2] * c01[2] - v0[3] * c01[3]; o0[3] = v0[3] * c01[2] + v0[2] * c01[3];
    o1[0] = v1[0] * c23[0] - v1[1] * c23[1]; o1[1] = v1[1] * c23[0] + v1[0] * c23[1];
    o1[2] = v1[2] * c23[2] - v1[3] * c23[3]; o1[3] = v1[3] * c23[2] + v1[2] * c23[3];
    v0 = o0; v1 = o1;
}

__device__ __forceinline__ unsigned pack4_fp8(const f32x4 v) {
    const float a = __builtin_fminf(__builtin_fmaxf(v[0], -448.f), 448.f), b = __builtin_fminf(__builtin_fmaxf(v[1], -448.f), 448.f), c = __builtin_fminf(__builtin_fmaxf(v[2], -448.f), 448.f), d = __builtin_fminf(__builtin_fmaxf(v[3], -448.f), 448.f);
    int p = __builtin_amdgcn_cvt_pk_fp8_f32(a, b, 0, false); p = __builtin_amdgcn_cvt_pk_fp8_f32(c, d, p, true); return (unsigned)p;
}
constexpr float ACT_F8_SCALE = 2.0f, WD_F8_SCALE = 512.0f, H_F8_SCALE = 16.0f, WGU_F8_SCALE = 256.0f;
template <bool F8OUT> struct EpiSwiglu {
    static constexpr bool PERM = true, AFTER_DRAIN = false;
    GAS unsigned char* O; int ldc; const gf32* RS; float pre;
    __device__ __forceinline__ void operator()(const f32x4 (&acc)[2][2][4][2], const Unit& u, int wr, int wc, int fr, int fq) const {
        const int row0 = u.pm * BM + wr * 64 + fr, col0 = u.pn * HALF + wc * 32 + 8 * fq; const float os = F8OUT ? ACT_F8_SCALE : 1.0f;
#pragma unroll
        for (int ai = 0; ai < 2; ++ai)
#pragma unroll
            for (int m = 0; m < 4; ++m) { const int row = row0 + ai * HALF + m * 16; const float rs = RS[row] * pre;
                f32x4 v0, v1;
#pragma unroll
                for (int e = 0; e < 4; ++e) { v0[e] = silu_f(acc[ai][0][m][0][e] * rs) * (acc[ai][1][m][0][e] * (rs * os)); v1[e] = silu_f(acc[ai][0][m][1][e] * rs) * (acc[ai][1][m][1][e] * (rs * os)); }
                if constexpr (F8OUT) { u32x2 w; w.x = pack4_fp8(v0); w.y = pack4_fp8(v1); *(GAS u32x2*)(O + (size_t)row * ldc + col0) = w; }
                else *(GAS u32x4*)((gbf16*)O + (size_t)row * ldc + col0) = pack8(v0, v1); }
    }
};
template <bool F8OUT> struct EpiSwigluQ {
    static constexpr bool PERM = true, AFTER_DRAIN = false;
    GAS unsigned char* O; int ldc; const gf32* RSX; const gf32* SC;
    __device__ __forceinline__ void operator()(const f32x4 (&acc)[2][2][4][2], const Unit& u, int wr, int wc, int fr, int fq) const {
        const int row0 = u.pm * BM + wr * 64 + fr, col0 = u.pn * HALF + wc * 32 + 8 * fq, cg = u.pn * BM + wc * 32 + 8 * fq;
        const GAS f32x4* sp = (const GAS f32x4*)(SC + cg); const float os = F8OUT ? ACT_F8_SCALE : 1.0f;
        const f32x4 sg0 = sp[0] * (CLIPF / 127.0f), sg1 = sp[1] * (CLIPF / 127.0f), su0 = sp[32] * (CLIPF / 127.0f), su1 = sp[33] * (CLIPF / 127.0f);
#pragma unroll
        for (int ai = 0; ai < 2; ++ai)
#pragma unroll
            for (int m = 0; m < 4; ++m) { const int row = row0 + ai * HALF + m * 16; const float rs = RSX[row];
                const i32x4 g0 = __builtin_bit_cast(i32x4, acc[ai][0][m][0]), g1 = __builtin_bit_cast(i32x4, acc[ai][0][m][1]), u0 = __builtin_bit_cast(i32x4, acc[ai][1][m][0]), u1 = __builtin_bit_cast(i32x4, acc[ai][1][m][1]);
                f32x4 v0, v1;
#pragma unroll
                for (int e = 0; e < 4; ++e) { v0[e] = silu_f((float)g0[e] * (rs * sg0[e])) * ((float)u0[e] * (rs * su0[e] * os)); v1[e] = silu_f((float)g1[e] * (rs * sg1[e])) * ((float)u1[e] * (rs * su1[e] * os)); }
                if constexpr (F8OUT) { u32x2 w; w.x = pack4_fp8(v0); w.y = pack4_fp8(v1); *(GAS u32x2*)(O + (size_t)row * ldc + col0) = w; }
                else *(GAS u32x4*)((gbf16*)O + (size_t)row * ldc + col0) = pack8(v0, v1); }
    }
};
struct EpiF {
    static constexpr bool PERM = true, AFTER_DRAIN = false;
    gbf16* O; int ldc; gf32* SS; int ldss; float scale; const gf32* RS; float pre;
    __device__ __forceinline__ void operator()(const f32x4 (&acc)[2][2][4][2], const Unit& u, int wr, int wc, int fr, int fq) const {
        const int row0 = u.pm * BM + wr * 64 + fr, col0 = u.pn * BM + wc * 32 + 8 * fq;
#pragma unroll
        for (int ai = 0; ai < 2; ++ai)
#pragma unroll
            for (int m = 0; m < 4; ++m) { const int row = row0 + ai * HALF + m * 16; gbf16* rowp = O + (size_t)row * ldc + col0; float s = 0.f; const float sc = RS ? scale * RS[row] : scale;
#pragma unroll
                for (int bj = 0; bj < 2; ++bj) { const f32x4 v0 = acc[ai][bj][m][0] * pre, v1 = acc[ai][bj][m][1] * pre; s += sq8(v0, v1); *(GAS u32x4*)(rowp + bj * HALF) = pack8(v0 * sc, v1 * sc); }
                if (SS) { s += __shfl_xor(s, 16); s += __shfl_xor(s, 32); if (fq == 0) SS[(size_t)row * ldss + u.pn * 4 + wc] = s; } }
    }
};
template <bool Q> struct EpiInProj {
    static constexpr bool PERM = true, AFTER_DRAIN = false;
    gbf16* U; gf32* SSQ; gf32* SSKV; gbf16* KPE; const GAS f32x2* ROPE; float qscale; const gf32* RS; const gf32* SC; int pn0;
    __device__ __forceinline__ void operator()(const f32x4 (&acc)[2][2][4][2], const Unit& u, int wr, int wc, int fr, int fq) const {
        const int row0 = u.pm * BM + wr * 64 + fr, pn = u.pn + pn0;
        f32x4 cs[2][2];
        if constexpr (Q) { const GAS f32x4* sp = (const GAS f32x4*)(SC + pn * BM + wc * 32 + 8 * fq); cs[0][0] = sp[0] * (CLIPF / 127.0f); cs[0][1] = sp[1] * (CLIPF / 127.0f); cs[1][0] = sp[32] * (CLIPF / 127.0f); cs[1][1] = sp[33] * (CLIPF / 127.0f); }
#define IP_ACC(ai, bj, m, n) (Q ? __builtin_convertvector(__builtin_bit_cast(i32x4, acc[ai][bj][m][n]), f32x4) * cs[bj][n] : acc[ai][bj][m][n])
        if (pn < 30) {
            const float sc = pn < 8 ? qscale : 1.0f; const int col0 = pn * BM + wc * 32 + 8 * fq;
            gf32* ssp = nullptr; int ldss = 0;
            if (pn >= 24 && pn < 28) { ssp = SSQ + (pn - 24) * 4 + wc; ldss = 16; } else if (pn >= 28) { ssp = SSKV + (pn - 28) * 4 + wc; ldss = 8; }
#pragma unroll
            for (int ai = 0; ai < 2; ++ai)
#pragma unroll
                for (int m = 0; m < 4; ++m) { const int row = row0 + ai * HALF + m * 16; gbf16* rowp = U + (size_t)row * INWP + col0; float s = 0.f; const float rs = RS[row];
#pragma unroll
                    for (int bj = 0; bj < 2; ++bj) { const f32x4 v0 = IP_ACC(ai, bj, m, 0) * rs, v1 = IP_ACC(ai, bj, m, 1) * rs; s += sq8(v0, v1); *(GAS u32x4*)(rowp + bj * HALF) = pack8(v0 * sc, v1 * sc); }
                    if (ssp) { s += __shfl_xor(s, 16); s += __shfl_xor(s, 32); if (fq == 0) ssp[(size_t)row * ldss] = s; } }
        } else if (wc < 2) {
#pragma unroll
            for (int ai = 0; ai < 2; ++ai)
#pragma unroll
                for (int m = 0; m < 4; ++m) { const int row = row0 + ai * HALF + m * 16; const float rs = RS[row]; f32x4 v0 = IP_ACC(ai, 0, m, 0) * rs, v1 = IP_ACC(ai, 0, m, 1) * rs;
                    rope8(v0, v1, ROPE + (size_t)row * 32 + 16 * wc + 4 * fq);
                    *(GAS u32x4*)(KPE + (size_t)row * 64 + 32 * wc + 8 * fq) = pack8(v0, v1); }
        }
#undef IP_ACC
    }
};
struct EpiQb {
    static constexpr bool PERM = true, AFTER_DRAIN = false;
    gbf16* O; const gf32* SSQ; const GAS f32x2* ROPE; float scale;
    __device__ __forceinline__ void operator()(const f32x4 (&acc)[2][2][4][2], const Unit& u, int wr, int wc, int fr, int fq) const {
        const int row0 = u.pm * BM + wr * 64 + fr;
#pragma unroll
        for (int ai = 0; ai < 2; ++ai)
#pragma unroll
            for (int m = 0; m < 4; ++m) { const int row = row0 + ai * HALF + m * 16;
                const GAS f32x4* sp = (const GAS f32x4*)(SSQ + (size_t)row * 16); const f32x4 a = sp[0], b = sp[1], c = sp[2], d = sp[3];
                const float ss = ((a[0] + a[1]) + (a[2] + a[3])) + ((b[0] + b[1]) + (b[2] + b[3])) + ((c[0] + c[1]) + (c[2] + c[3])) + ((d[0] + d[1]) + (d[2] + d[3]));
                const float rs = rsqrtf(ss * (1.0f / QRANK) + EPS) * scale;
#pragma unroll
                for (int bj = 0; bj < 2; ++bj) { const int cw = u.pn * BM + bj * HALF + wc * 32, jw = cw % MLA_QD;
                    f32x4 v0 = acc[ai][bj][m][0] * rs, v1 = acc[ai][bj][m][1] * rs;
                    if (jw >= 128) rope8(v0, v1, ROPE + (size_t)row * 32 + ((jw - 128) >> 1) + 4 * fq);
                    *(GAS u32x4*)(O + (size_t)row * QBW + cw + 8 * fq) = pack8(v0, v1); } }
    }
};
struct EpiKvb {
    static constexpr bool PERM = true, AFTER_DRAIN = false;
    gbf16* O; const gf32* SSKV;
    __device__ __forceinline__ void operator()(const f32x4 (&acc)[2][2][4][2], const Unit& u, int wr, int wc, int fr, int fq) const {
        const int row0 = u.pm * BM + wr * 64 + fr, col0 = u.pn * BM + wc * 32 + 8 * fq;
#pragma unroll
        for (int ai = 0; ai < 2; ++ai)
#pragma unroll
            for (int m = 0; m < 4; ++m) { const int row = row0 + ai * HALF + m * 16;
                const GAS f32x4* sp = (const GAS f32x4*)(SSKV + (size_t)row * 8); const f32x4 a = sp[0], b = sp[1];
                const float ss = ((a[0] + a[1]) + (a[2] + a[3])) + ((b[0] + b[1]) + (b[2] + b[3]));
                const float rs = rsqrtf(ss * (1.0f / KVRANK) + EPS);
#pragma unroll
                for (int bj = 0; bj < 2; ++bj) *(GAS u32x4*)(O + (size_t)row * KVBW + col0 + bj * HALF) = pack8(acc[ai][bj][m][0] * rs, acc[ai][bj][m][1] * rs); }
    }
};

template <class Epi, class Sched, bool ALIGN_EPI = true, bool F8 = false, bool I8 = false>
__device__ __forceinline__ void gemm_phase(LAS unsigned char* lds, const Gemm g, const Sched& S, const Epi& E, int wave_) {
    const int wid = wave_, lane = lane_id_fresh(), tid = wid * 64 + lane, wr = wid >> 2, wc = wid & 3, fr = lane & 15, fq = lane >> 4;
    const int K = g.K, nt = K / BK;
    unsigned voffA[2], voffB[2];
#pragma unroll
    for (int i = 0; i < 2; ++i) { int R, C; stage_rc(tid * 16 + i * 8192, R, C); const int Rb = Epi::PERM ? ((R & ~31) + perm32(R & 31)) : R;
        voffA[i] = (unsigned)(R * g.lda + C) * 2u; voffB[i] = (unsigned)(Rb * g.ldb + C) * 2u; }
    const size_t kstep = (size_t)(BK * 2);
    const size_t hA = (size_t)HALF * g.lda * 2, hB = (size_t)HALF * g.ldb * 2, tA = 2 * hA, tB = 2 * hB;
    const unsigned ldsw = (unsigned)wid * 1024u;
    const int aoff = F8 ? lds_byte(wr * 64 + fr, (fq >> 1) * 32 + (fq & 1) * 16) : lds_byte(wr * 64 + fr, fq * 8), boff = F8 ? lds_byte(wc * 32 + fr, (fq >> 1) * 32 + (fq & 1) * 16) : lds_byte(wc * 32 + fr, fq * 8);
#define PG8_SA(b, h) (((b) * 2 + (h)) * HTB)
#define PG8_SB(b, h) ((4 + (b) * 2 + (h)) * HTB)
#define PG8_STAGE(bufoff, gbase, voff) do { _Pragma("unroll") for (int _i = 0; _i < 2; ++_i) { unsigned vo_ = (voff)[_i]; if constexpr (F8) asm volatile("" : "+v"(vo_));     \
        __builtin_amdgcn_global_load_lds((const GAS unsigned*)((const GAS char*)(gbase) + vo_), (LAS unsigned*)(lds + (bufoff) + ldsw + _i * 8192), 16, 0, 0); } } while (0)
#define PG8_LD8(p) __builtin_shufflevector(*(const LAS i32x4*)(p), *(const LAS i32x4*)((p) + 16), 0, 1, 2, 3, 4, 5, 6, 7)
#define PG8_LDA(dst, b, h) do { _Pragma("unroll") for (int m = 0; m < 4; ++m) { if constexpr (F8) dst##8[m] = PG8_LD8(lds + PG8_SA(b, h) + aoff + m * 2048); else { _Pragma("unroll") for (int k = 0; k < 2; ++k) dst[m][k] = *(const LAS bf16x8*)(lds + PG8_SA(b, h) + aoff + m * 2048 + k * 1024); } } } while (0)
#define PG8_LDB(dst, b, h) do { _Pragma("unroll") for (int n = 0; n < 2; ++n) { if constexpr (F8) dst##8[n] = PG8_LD8(lds + PG8_SB(b, h) + boff + n * 2048); else { _Pragma("unroll") for (int k = 0; k < 2; ++k) dst[n][k] = *(const LAS bf16x8*)(lds + PG8_SB(b, h) + boff + n * 2048 + k * 1024); } } } while (0)
#define PG8_MMA(ai, bj, At, Bt) do { __builtin_amdgcn_s_setprio(1); _Pragma("unroll") for (int m = 0; m < 4; ++m) _Pragma("unroll") for (int n = 0; n < 2; ++n) { \
        if constexpr (F8) acc[ai][bj][m][n] = __builtin_amdgcn_mfma_scale_f32_16x16x128_f8f6f4(Bt##8[n], At##8[m], acc[ai][bj][m][n], 0, 0, 0, 0x7f7f7f7f, 0, 0x7f7f7f7f); \
        else if constexpr (I8) { _Pragma("unroll") for (int k = 0; k < 2; ++k) acc[ai][bj][m][n] = __builtin_bit_cast(f32x4, __builtin_amdgcn_mfma_i32_16x16x64_i8(__builtin_bit_cast(i32x4, Bt[n][k]), __builtin_bit_cast(i32x4, At[m][k]), __builtin_bit_cast(i32x4, acc[ai][bj][m][n]), 0, 0, 0)); } \
        else { _Pragma("unroll") for (int k = 0; k < 2; ++k) acc[ai][bj][m][n] = __builtin_amdgcn_mfma_f32_16x16x32_bf16(Bt[n][k], At[m][k], acc[ai][bj][m][n], 0, 0, 0); } } \
        __builtin_amdgcn_s_setprio(0); } while (0)
#define PG8_WAIT_V(n) asm volatile("s_waitcnt vmcnt(" #n ")" ::: "memory")
#define PG8_WAIT_L(n) asm volatile("s_waitcnt lgkmcnt(" #n ")" ::: "memory")
#define PG8_BAR __builtin_amdgcn_s_barrier()
#define PG8_SCHED __builtin_amdgcn_sched_barrier(0)
    Unit cur, nxt; int ui = 0;
    if (!S.next(0, cur)) return;
    f32x4 acc[2][2][4][2];
#pragma unroll
    for (int a = 0; a < 2; ++a)
#pragma unroll
        for (int b = 0; b < 2; ++b)
#pragma unroll
            for (int m = 0; m < 4; ++m)
#pragma unroll
                for (int n = 0; n < 2; ++n) acc[a][b][m][n] = (f32x4){0.f, 0.f, 0.f, 0.f};
    bf16x8 At[4][2], B0[2][2], B1[2][2]; i32x8 At8[4], B08[2], B18[2];
    const GAS char* cA = (const GAS char*)g.A + (size_t)cur.pm * tA; const GAS char* cB = (const GAS char*)g.Bt + (size_t)cur.pn * tB;
    S.a_ready(cur);
    PG8_STAGE(PG8_SB(0, 0), cB, voffB); PG8_STAGE(PG8_SB(0, 1), cB + hB, voffB); PG8_STAGE(PG8_SA(0, 0), cA, voffA); PG8_STAGE(PG8_SA(0, 1), cA + hA, voffA);
    if (wr == 1) PG8_BAR;
    PG8_WAIT_V(2); PG8_BAR;
    PG8_STAGE(PG8_SB(1, 0), cB + kstep, voffB); PG8_STAGE(PG8_SA(1, 0), cA + kstep, voffA); PG8_STAGE(PG8_SB(1, 1), cB + hB + kstep, voffB);
    PG8_WAIT_V(6); PG8_BAR;
    for (;;) {
        const bool has_next = S.next(ui + 1, nxt);
        const GAS char* nA = has_next ? (const GAS char*)g.A + (size_t)nxt.pm * tA : cA; const GAS char* nB = has_next ? (const GAS char*)g.Bt + (size_t)nxt.pn * tB : cB;
        for (int t = 0; t < nt; t += 2) {
            const bool last = (t == nt - 2);
            const GAS char* a1 = cA + (size_t)(t + 1) * kstep;
            const GAS char* a2 = last ? nA : cA + (size_t)(t + 2) * kstep; const GAS char* b2 = last ? nB : cB + (size_t)(t + 2) * kstep;
            const GAS char* a3 = a2 + kstep; const GAS char* b3 = b2 + kstep;
            if (last && has_next) S.a_ready(nxt);
            PG8_LDB(B0, 0, 0); PG8_LDB(B1, 0, 1); PG8_SCHED; PG8_LDA(At, 0, 0); PG8_STAGE(PG8_SA(1, 1), a1 + hA, voffA);
            PG8_WAIT_V(8); PG8_WAIT_L(0); PG8_BAR; PG8_MMA(0, 0, At, B0); PG8_MMA(0, 1, At, B1); PG8_BAR; PG8_SCHED;
            PG8_LDA(At, 0, 1); PG8_STAGE(PG8_SB(0, 0), b2, voffB); PG8_STAGE(PG8_SB(0, 1), b2 + hB, voffB); PG8_STAGE(PG8_SA(0, 0), a2, voffA);
            PG8_WAIT_V(8); PG8_WAIT_L(0); PG8_BAR; PG8_MMA(1, 0, At, B0); PG8_MMA(1, 1, At, B1); PG8_BAR; PG8_SCHED;
            PG8_LDB(B0, 1, 0); PG8_LDB(B1, 1, 1); PG8_SCHED; PG8_LDA(At, 1, 0); PG8_STAGE(PG8_SA(0, 1), a2 + hA, voffA);
            PG8_WAIT_V(8); PG8_WAIT_L(0); PG8_BAR; PG8_MMA(0, 0, At, B0); PG8_MMA(0, 1, At, B1); PG8_BAR; PG8_SCHED;
            PG8_LDA(At, 1, 1); PG8_STAGE(PG8_SB(1, 0), b3, voffB); PG8_STAGE(PG8_SB(1, 1), b3 + hB, voffB); PG8_STAGE(PG8_SA(1, 0), a3, voffA);
            PG8_WAIT_V(8); PG8_WAIT_L(0); PG8_BAR; PG8_MMA(1, 0, At, B0); PG8_MMA(1, 1, At, B1); PG8_BAR; PG8_SCHED;
        }
        if constexpr (ALIGN_EPI) { if (wr == 0) PG8_BAR; }
        { const int l_ = lane_id_fresh(); E(acc, cur, wr, wc, l_ & 15, l_ >> 4); } S.done(cur);
        if (!has_next) break;
#pragma unroll
        for (int a = 0; a < 2; ++a)
#pragma unroll
            for (int b = 0; b < 2; ++b)
#pragma unroll
                for (int m = 0; m < 4; ++m)
#pragma unroll
                    for (int n = 0; n < 2; ++n) acc[a][b][m][n] = (f32x4){0.f, 0.f, 0.f, 0.f};
        cur = nxt; cA = nA; cB = nB; ++ui;
        if constexpr (ALIGN_EPI) { if (wr == 1) PG8_BAR; }
    }
    PG8_WAIT_V(0);
    if constexpr (!ALIGN_EPI) { if (wr == 0) PG8_BAR; }
    PG8_BAR;
#undef PG8_SA
#undef PG8_SB
#undef PG8_STAGE
#undef PG8_LDA
#undef PG8_LDB
#undef PG8_MMA
#undef PG8_WAIT_V
#undef PG8_WAIT_L
#undef PG8_BAR
#undef PG8_SCHED
}
}

namespace att {
constexpr int KVBLK = 64, QBLK = 32, DV = 128;
constexpr int SHM_V = KVBLK * DV * 2;
constexpr float THR2 = 11.5f;
constexpr float MASKV = -3.0e30f;
#define SBAR() __builtin_amdgcn_sched_barrier(0)
__device__ __forceinline__ int crow(int r, int hi) { return (r & 3) + 8 * (r >> 2) + 4 * hi; }
template <int DQK> __device__ __forceinline__ int kswz(int row, int colB) {
    if constexpr (DQK == 128) return row * 256 + (colB ^ ((row & 7) << 4));
    else return row * 384 + (colB ^ (((row >> 1) & 7) << 4));
}
__device__ __forceinline__ int v_st(int k, int c) { const int kk = (k & ~0xC) | ((k & 4) << 1) | ((k & 8) >> 1); return ((kk >> 3) * 4 + (c >> 5)) * 512 + ((kk & 7) * 32 + (c & 31)) * 2; }
__device__ __forceinline__ int v_rd_base(int lane) { return ((lane & 3) << 3) | (((lane >> 2) & 3) << 6) | (((lane >> 4) & 1) << 5) | (((lane >> 5) & 1) << 8); }
constexpr int v_rd_off(int d0, int ks, int half) { return d0 * 512 + ks * 4096 + half * 2048; }
template <int OFF> __device__ __forceinline__ s16x4 tr_read(int vb) {
    s16x4 r; asm volatile("ds_read_b64_tr_b16 %0, %1 offset:%2" : "=&v"(r) : "v"(vb), "i"(OFF) : "memory"); return r;
}
template <int D0> __device__ __forceinline__ void pv_one(f32x16& od, int vb, bf16x8 pa0, bf16x8 pa1, bf16x8 pa2, bf16x8 pa3) {
    const s16x4 l0 = tr_read<v_rd_off(D0, 0, 0)>(vb), h0 = tr_read<v_rd_off(D0, 0, 1)>(vb), l1 = tr_read<v_rd_off(D0, 1, 0)>(vb), h1 = tr_read<v_rd_off(D0, 1, 1)>(vb);
    const s16x4 l2 = tr_read<v_rd_off(D0, 2, 0)>(vb), h2 = tr_read<v_rd_off(D0, 2, 1)>(vb), l3 = tr_read<v_rd_off(D0, 3, 0)>(vb), h3 = tr_read<v_rd_off(D0, 3, 1)>(vb);
    asm volatile("s_waitcnt lgkmcnt(0)" ::: "memory"); SBAR();
#define PK(L, H) (bf16x8){L[0], L[1], L[2], L[3], H[0], H[1], H[2], H[3]}
    od = __builtin_amdgcn_mfma_f32_32x32x16_bf16(pa0, PK(l0, h0), od, 0, 0, 0);
    od = __builtin_amdgcn_mfma_f32_32x32x16_bf16(pa1, PK(l1, h1), od, 0, 0, 0);
    od = __builtin_amdgcn_mfma_f32_32x32x16_bf16(pa2, PK(l2, h2), od, 0, 0, 0);
    od = __builtin_amdgcn_mfma_f32_32x32x16_bf16(pa3, PK(l3, h3), od, 0, 0, 0);
#undef PK
}
__device__ __forceinline__ void pv_d0(f32x16* o, int vb, bf16x8 pa0, bf16x8 pa1, bf16x8 pa2, bf16x8 pa3) {
    pv_one<0>(o[0], vb, pa0, pa1, pa2, pa3); pv_one<1>(o[1], vb, pa0, pa1, pa2, pa3); pv_one<2>(o[2], vb, pa0, pa1, pa2, pa3); pv_one<3>(o[3], vb, pa0, pa1, pa2, pa3);
}
__device__ __forceinline__ void partialSM(f32x16& p0, f32x16& p1, float& m_reg, float& mn, float& alpha) {
    float pmax = p0[0];
#pragma unroll
    for (int r = 1; r < 16; ++r) pmax = fmaxf(pmax, p0[r]);
#pragma unroll
    for (int r = 0; r < 16; ++r) pmax = fmaxf(pmax, p1[r]);
    { auto rr = __builtin_amdgcn_permlane32_swap(__float_as_uint(pmax), __float_as_uint(pmax), false, false);
      pmax = fmaxf(__uint_as_float(rr[0]), __uint_as_float(rr[1])); }
    if (__builtin_expect(__all(pmax - m_reg <= THR2), 1)) { mn = m_reg; alpha = 1.f; }
    else { mn = fmaxf(m_reg, pmax); alpha = __builtin_amdgcn_exp2f(m_reg - mn); m_reg = mn; }
#pragma unroll
    for (int r = 0; r < 16; ++r) p0[r] = p0[r] - mn;
#pragma unroll
    for (int r = 0; r < 16; ++r) p1[r] = p1[r] - mn;
#pragma unroll
    for (int r = 0; r < 16; ++r) p0[r] = __builtin_amdgcn_exp2f(p0[r]);
}
__device__ __forceinline__ void finishSM(f32x16& p0, f32x16& p1, float alpha, float& l_reg, bf16x8& pa0, bf16x8& pa1, bf16x8& pa2, bf16x8& pa3) {
#pragma unroll
    for (int r = 0; r < 16; ++r) p1[r] = __builtin_amdgcn_exp2f(p1[r]);
    float ps = 0;
#pragma unroll
    for (int r = 0; r < 16; ++r) ps += p0[r];
#pragma unroll
    for (int r = 0; r < 16; ++r) ps += p1[r];
    { auto rr = __builtin_amdgcn_permlane32_swap(__float_as_uint(ps), __float_as_uint(ps), false, false);
      ps = __uint_as_float(rr[0]) + __uint_as_float(rr[1]); }
    l_reg = l_reg * alpha + ps;
#define PK4(P, BASE, OUT) do { unsigned a0 = cvt_pk_bf16(P[BASE + 0], P[BASE + 1]), a1 = cvt_pk_bf16(P[BASE + 2], P[BASE + 3]);   \
    unsigned b0 = cvt_pk_bf16(P[BASE + 4], P[BASE + 5]), b1 = cvt_pk_bf16(P[BASE + 6], P[BASE + 7]);                              \
    auto r0 = __builtin_amdgcn_permlane32_swap(a0, b0, false, false); auto r1 = __builtin_amdgcn_permlane32_swap(a1, b1, false, false); \
    u32x4 w = {r0[0], r1[0], r0[1], r1[1]}; OUT = __builtin_bit_cast(bf16x8, w); } while (0)
    PK4(p0, 0, pa0); PK4(p0, 8, pa1); PK4(p1, 0, pa2); PK4(p1, 8, pa3);
#undef PK4
}
template <int DQK, int QREG> __device__ __forceinline__ void qkt(f32x16& p0, f32x16& p1, LAS const char* Ks, const bf16x8* qr, LAS const char* ql, int r32, int hi) {
    p0 = f32x16{}; p1 = f32x16{};
#pragma unroll
    for (int d0 = 0; d0 < DQK / 16; ++d0) { const int cb = (d0 * 16 + hi * 8) * 2;
        const bf16x8 b0 = *(LAS const bf16x8*)(Ks + kswz<DQK>(r32, cb));
        const bf16x8 b1 = *(LAS const bf16x8*)(Ks + kswz<DQK>(32 + r32, cb));
        bf16x8 q; if (d0 < QREG) q = qr[d0 < QREG ? d0 : 0]; else q = *(LAS const bf16x8*)(ql + (d0 - QREG) * 1024);
        p0 = __builtin_amdgcn_mfma_f32_32x32x16_bf16(b0, q, p0, 0, 0, 0);
        p1 = __builtin_amdgcn_mfma_f32_32x32x16_bf16(b1, q, p1, 0, 0, 0); }
}
struct NaCtx { int KR0, rs, rw, qc, cst; LAS const float* bias; const gf32* qrs; float qscale; size_t qstride; };
__device__ __forceinline__ void na_mask(f32x16& p0, f32x16& p1, const NaCtx& c, int t, int hi) {
    const int krl = c.KR0 + t; const bool rowok = (krl >= c.rs) && (krl < c.rs + 8);
    if (!rowok) {
#pragma unroll
        for (int r = 0; r < 16; ++r) { p0[r] = MASKV; p1[r] = MASKV; }
    } else {
        LAS const float* brow = c.bias + (krl - c.rw + 7) * 32 + 15 - c.qc;
#pragma unroll
        for (int r = 0; r < 16; ++r) {
            const int k0 = crow(r, hi), k1 = k0 + 32;
            const bool ok0 = (unsigned)(k0 - c.cst) < 16u, ok1 = (unsigned)(k1 - c.cst) < 16u;
            const float b0 = ok0 ? brow[k0] : 0.f, b1 = ok1 ? brow[k1] : 0.f;
            p0[r] = ok0 ? p0[r] + b0 : MASKV; p1[r] = ok1 ? p1[r] + b1 : MASKV;
            if ((r & 3) == 3) asm volatile("" ::: "memory");
        }
    }
}

template <int DQK, int MODE, int QREG, int QMODE, bool G1>
__device__ __forceinline__ void attn_unit_impl(const gbf16* __restrict__ Qb, int ldq, const gbf16* __restrict__ Kb, int ldk, const gbf16* __restrict__ Kpe,
                                          const gbf16* __restrict__ Vb, int ldv, gbf16* __restrict__ Ob, int ldo, int NT, LAS char* lds, NaCtx nc, int wave_) {
    constexpr int SHM_K = KVBLK * DQK * 2;
    const int wid = wave_, lane = lane_id_fresh(), tid = wid * 64 + lane, r32 = lane & 31, hi = lane >> 5;
#ifdef DBG_NO_ATT
    for (int i = tid; i < 256 * 16; i += 512) { const int r = i >> 4, c = (i & 15) * 8; *(GAS bf16x8*)(Ob + (size_t)r * ldo + c) = *(const GAS bf16x8*)(Qb + (size_t)r * ldq + c); }
    return;
#endif
    LAS char* V_lds = lds; LAS char* K_lds = lds + 2 * SHM_V;
    LAS float* ws = (LAS float*)(lds + 2 * SHM_V + 2 * SHM_K) + wid * 64; LAS float* li_l = ws; LAS float* al_l = ws + 32;
    constexpr int QL = DQK / 16 - QREG;
    LAS char* ql = lds + 2 * SHM_V + 2 * SHM_K + 2048 + wid * (QL * 1024) + lane * 16;
    float m_reg = -1e30f, l_reg = 0; f32x16 o[4] = {}; bf16x8 qr[QREG];
    const gbf16* Qw = Qb + (size_t)(wid * QBLK + r32) * ldq + hi * 8;
    if constexpr (QMODE == 1) {
        const float qsc = nc.qrs[nc.KR0 + wid * QBLK + r32] * nc.qscale;
#pragma unroll
        for (int d0 = 0; d0 < QREG; ++d0) { f32x4 lo = {0.f, 0.f, 0.f, 0.f}, hi4 = {0.f, 0.f, 0.f, 0.f};
#pragma unroll
            for (int sp = 0; sp < 4; ++sp) { const u32x4 w = *(const GAS u32x4*)(Qw + sp * nc.qstride + d0 * 16);
                lo[0] += bf_lo(w.x); lo[1] += bf_hi(w.x); lo[2] += bf_lo(w.y); lo[3] += bf_hi(w.y); hi4[0] += bf_lo(w.z); hi4[1] += bf_hi(w.z); hi4[2] += bf_lo(w.w); hi4[3] += bf_hi(w.w); }
            u32x4 p; p.x = cvt_pk_bf16(lo[0] * qsc, lo[1] * qsc); p.y = cvt_pk_bf16(lo[2] * qsc, lo[3] * qsc); p.z = cvt_pk_bf16(hi4[0] * qsc, hi4[1] * qsc); p.w = cvt_pk_bf16(hi4[2] * qsc, hi4[3] * qsc);
            qr[d0] = __builtin_bit_cast(bf16x8, p); }
    } else {
#pragma unroll
    for (int d0 = 0; d0 < QREG; ++d0) qr[d0] = *(const GAS bf16x8*)(Qw + d0 * 16);
    }
#pragma unroll
    for (int d0 = QREG; d0 < DQK / 16; ++d0) *(LAS bf16x8*)(ql + (d0 - QREG) * 1024) = *(const GAS bf16x8*)(Qw + d0 * 16);
    const int sr = tid >> 4, sc = (tid & 15) * 8, vst0 = v_st(sr, sc), vst1 = v_st(32 + sr, sc);
    const int pr = tid >> 3, pc = (tid & 7) * 8;
    const int vb0 = (int)(unsigned)(uintptr_t)V_lds + v_rd_base(lane);
    bf16x8 vs0, vs1, ks0, ks1, kp0;
#define KEY0(t) ((MODE == 1 ? ((nc.KR0 + (t)) > 31 ? 31 : (nc.KR0 + (t))) : (t)) * KVBLK)
#define SLOAD(t) do { const int k0_ = KEY0(t); vs0 = *(const GAS bf16x8*)(Vb + (size_t)(k0_ + sr) * ldv + sc); vs1 = *(const GAS bf16x8*)(Vb + (size_t)(k0_ + 32 + sr) * ldv + sc); \
    ks0 = *(const GAS bf16x8*)(Kb + (size_t)(k0_ + sr) * ldk + sc); ks1 = *(const GAS bf16x8*)(Kb + (size_t)(k0_ + 32 + sr) * ldk + sc); \
    if constexpr (DQK == 192) kp0 = *(const GAS bf16x8*)(Kpe + (size_t)(k0_ + pr) * 64 + pc); } while (0)
#define SWRITE(b) do { *(LAS bf16x8*)(V_lds + (b) * SHM_V + vst0) = vs0; *(LAS bf16x8*)(V_lds + (b) * SHM_V + vst1) = vs1; \
    *(LAS bf16x8*)(K_lds + (b) * SHM_K + kswz<DQK>(sr, sc * 2)) = ks0; *(LAS bf16x8*)(K_lds + (b) * SHM_K + kswz<DQK>(32 + sr, sc * 2)) = ks1; \
    if constexpr (DQK == 192) *(LAS bf16x8*)(K_lds + (b) * SHM_K + kswz<DQK>(pr, 256 + pc * 2)) = kp0; } while (0)
#define RESC(a) do { if (__any((a) < 1.f)) { if (hi == 0) al_l[r32] = (a); asm volatile("s_waitcnt lgkmcnt(0)" ::: "memory"); \
    _Pragma("unroll") for (int d = 0; d < 4; ++d) _Pragma("unroll") for (int r = 0; r < 16; ++r) o[d][r] *= al_l[crow(r, hi)]; } } while (0)
    f32x16 pA0, pA1, pB0, pB1; float mnA, mnB, alA, alB; bf16x8 pa0, pa1, pa2, pa3;
    SLOAD(0); VM_WAIT(); SWRITE(0); __syncthreads();
    alA = 1.f; alB = 1.f; mnA = 0.f; mnB = 0.f;
    if (MODE != 1 || ((unsigned)(nc.KR0 - nc.rs) < 8u)) { qkt<DQK, QREG>(pA0, pA1, K_lds, qr, ql, r32, hi); if constexpr (MODE == 1) na_mask(pA0, pA1, nc, 0, hi); partialSM(pA0, pA1, m_reg, mnA, alA); }
    SLOAD(1); VM_WAIT(); SWRITE(1); __syncthreads();
#define ACT(t) (MODE != 1 || ((unsigned)(nc.KR0 + (t) - nc.rs) < 8u))
#define ATT_STEP(G1, QP0, QP1, KOFF, TJ, FP0, FP1, FAL, VOFF, MN, AL) do { const bool aQ_ = ACT(TJ), aF_ = ACT((TJ) - 1); SBAR(); \
        if (!(G1)) { if (aQ_) { qkt<DQK, QREG>(QP0, QP1, K_lds + (KOFF), qr, ql, r32, hi); if constexpr (MODE == 1) na_mask(QP0, QP1, nc, (TJ), hi); } SBAR(); if (aF_) finishSM(FP0, FP1, FAL, l_reg, pa0, pa1, pa2, pa3); } \
        else { if (aF_) finishSM(FP0, FP1, FAL, l_reg, pa0, pa1, pa2, pa3); SBAR(); if (aQ_) { qkt<DQK, QREG>(QP0, QP1, K_lds + (KOFF), qr, ql, r32, hi); if constexpr (MODE == 1) na_mask(QP0, QP1, nc, (TJ), hi); } } \
        SBAR(); if ((TJ) + 1 < NT) SLOAD((TJ) + 1); SBAR(); \
        if (!(G1)) { if (aF_) pv_d0(o, vb0 + (VOFF), pa0, pa1, pa2, pa3); SBAR(); if (aQ_) partialSM(QP0, QP1, m_reg, MN, AL); else AL = 1.f; } \
        else { if (aQ_) partialSM(QP0, QP1, m_reg, MN, AL); else AL = 1.f; SBAR(); if (aF_) pv_d0(o, vb0 + (VOFF), pa0, pa1, pa2, pa3); } } while (0)
#define ATT_LOOP(G1) for (int j = 1; j + 1 < NT; j += 2) { \
        ATT_STEP(G1, pB0, pB1, SHM_K, j, pA0, pA1, alA, 0, mnB, alB); \
        __syncthreads(); VM_WAIT(); SWRITE(0);                          \
        RESC(alB); __syncthreads(); \
        ATT_STEP(G1, pA0, pA1, 0, j + 1, pB0, pB1, alB, SHM_V, mnA, alA); \
        __syncthreads(); VM_WAIT(); SWRITE(1);                          \
        RESC(alA); __syncthreads(); }
    ATT_LOOP(G1)
#undef ATT_LOOP
#undef ATT_STEP
    { const bool aP = ACT(NT - 2), aB = ACT(NT - 1);
      SBAR(); if (aB) { qkt<DQK, QREG>(pB0, pB1, K_lds + SHM_K, qr, ql, r32, hi); if constexpr (MODE == 1) na_mask(pB0, pB1, nc, NT - 1, hi); }
      if (aP) finishSM(pA0, pA1, alA, l_reg, pa0, pa1, pa2, pa3); SBAR();
      if (aP) pv_d0(o, vb0, pa0, pa1, pa2, pa3);
      if (aB) { partialSM(pB0, pB1, m_reg, mnB, alB);
        RESC(alB);
        finishSM(pB0, pB1, alB, l_reg, pa0, pa1, pa2, pa3); SBAR();
        pv_d0(o, vb0 + SHM_V, pa0, pa1, pa2, pa3); } }
#undef ACT
    if (hi == 0) li_l[r32] = l_reg; asm volatile("s_waitcnt lgkmcnt(0)" ::: "memory");
    float rli[16];
#pragma unroll
    for (int r = 0; r < 16; ++r) rli[r] = __builtin_amdgcn_rcpf(li_l[crow(r, hi)]);
    gbf16* Ow = Ob + (size_t)(wid * QBLK) * ldo;
#pragma unroll
    for (int r = 0; r < 16; ++r) { const int orow = crow(r, hi);
#pragma unroll
        for (int d0 = 0; d0 < 4; ++d0) Ow[(size_t)orow * ldo + d0 * 32 + r32] = (bf16_t)(cvt_pk_bf16(o[d0][r] * rli[r], 0.f) & 0xffffu); }
    __syncthreads();
#undef KEY0
#undef SLOAD
#undef SWRITE
#undef RESC
}
template <int DQK, int MODE, int QREG, int QMODE = 0>
__device__ __forceinline__ void attn_unit(const gbf16* __restrict__ Qb, int ldq, const gbf16* __restrict__ Kb, int ldk, const gbf16* __restrict__ Kpe,
                                          const gbf16* __restrict__ Vb, int ldv, gbf16* __restrict__ Ob, int ldo, int NT, LAS char* lds, NaCtx nc, int wave_) {
    if (wave_ < 4) attn_unit_impl<DQK, MODE, QREG, QMODE, false>(Qb, ldq, Kb, ldk, Kpe, Vb, ldv, Ob, ldo, NT, lds, nc, wave_);
    else attn_unit_impl<DQK, MODE, QREG, QMODE, true>(Qb, ldq, Kb, ldk, Kpe, Vb, ldv, Ob, ldo, NT, lds, nc, wave_);
}
}

#define XB_TMO      128
#define XB_XCNT(j)  (256  + 64 * (j))
#define XB_XSUB(j)  (1280 + 64 * (j))
#define XB_XGEN(j)  (2304 + 64 * (j))
#define XB_TOP      3328
#define XB_TOPGEN   3392
#define XCD_BAR_WORDS 3456
#define XB_SPIN_CAP (1u << 18)
__device__ __forceinline__ unsigned xb_ld(unsigned* p)              { return __hip_atomic_load(p, __ATOMIC_RELAXED, __HIP_MEMORY_SCOPE_AGENT); }
__device__ __forceinline__ unsigned xb_add(unsigned* p, unsigned v) { return __hip_atomic_fetch_add(p, v, __ATOMIC_RELAXED, __HIP_MEMORY_SCOPE_AGENT); }
__device__ __forceinline__ unsigned xb_xcc_id() { return (unsigned)__builtin_amdgcn_s_getreg((3 << 11) | 20) & 0xFu; }
#define XB_SPIN(cond, bar) do { unsigned _sp = 0; while (cond) { __builtin_amdgcn_s_sleep(1); \
    if ((++_sp & 255u) == 0u) { if (xb_ld(&(bar)[XB_TMO])) break; if (_sp > XB_SPIN_CAP) { atomicAdd(&(bar)[XB_TMO], 1u); break; } } } } while (0)
struct XcdBarrier { unsigned* bar; unsigned x; volatile LAS unsigned* st; };
__device__ __forceinline__ XcdBarrier xcd_barrier_post(unsigned* bar, volatile LAS unsigned* st) {
    XcdBarrier b; b.bar = bar; b.x = xb_xcc_id(); b.st = st;
    if (threadIdx.x == 0) (void)xb_add(&bar[XB_XCNT(b.x)], 1u);
    return b;
}
__device__ __forceinline__ void xcd_barrier_complete(unsigned* bar, unsigned x, unsigned& nloc, unsigned& nx) {
    const unsigned G = gridDim.x * gridDim.y * gridDim.z;
    unsigned sum, cnt, mine, sp = 0u;
    for (;;) {
        sum = 0u; cnt = 0u; mine = 0u;
#pragma unroll
        for (unsigned j = 0; j < 16; ++j) { const unsigned c = xb_ld(&bar[XB_XCNT(j)]); sum += c; cnt += (c > 0u) ? 1u : 0u; mine = (j == x) ? c : mine; }
        if (sum == G) break;
        __builtin_amdgcn_s_sleep(1);
        if ((++sp & 255u) == 0u) { if (xb_ld(&bar[XB_TMO])) break; if (sp > XB_SPIN_CAP) { atomicAdd(&bar[XB_TMO], 1u); break; } }
    }
    nloc = mine > 0u ? mine : 1u; nx = cnt > 0u ? cnt : 1u;
}
__device__ __forceinline__ void xcd_barrier(const XcdBarrier& b) {
    asm volatile("s_waitcnt vmcnt(0)" ::: "memory");
    __syncthreads();
    if (threadIdx.x == 0) {
        unsigned* bar = b.bar;
        __builtin_amdgcn_s_waitcnt(0);
        unsigned nloc = b.st[0], nx = b.st[1];
        if (nloc == 0u) { xcd_barrier_complete(bar, b.x, nloc, nx); b.st[0] = nloc; b.st[1] = nx; }
        const unsigned old = xb_add(&bar[XB_XSUB(b.x)], 1u);
        const unsigned gen = old / nloc;
        if (old + 1u == (gen + 1u) * nloc) {
            __builtin_amdgcn_fence(__ATOMIC_RELEASE, "agent");
            asm volatile("s_waitcnt vmcnt(0)" ::: "memory");
            const unsigned og = xb_add(&bar[XB_TOP], 1u);
            const unsigned tg = og / nx;
            if (og + 1u == (tg + 1u) * nx) xb_add(&bar[XB_TOPGEN], 1u);
            else XB_SPIN(xb_ld(&bar[XB_TOPGEN]) == tg, bar);
            __builtin_amdgcn_fence(__ATOMIC_ACQUIRE, "agent");
            xb_add(&bar[XB_XGEN(b.x)], 1u);
            asm volatile("s_waitcnt vmcnt(0)" ::: "memory");
        } else {
            XB_SPIN(xb_ld(&bar[XB_XGEN(b.x)]) == gen, bar);
            __builtin_amdgcn_fence(__ATOMIC_ACQUIRE, "agent");
            asm volatile("s_waitcnt vmcnt(0)" ::: "memory");
        }
    }
    __syncthreads();
}

template <int MODE> __device__ __forceinline__ int rowmap(int n, int row_off) {
    if constexpr (MODE == 0) return row_off + n;
    else if constexpr (MODE == 1) return ((n >> 7) << 8) + row_off + (n & 127);
    else if constexpr (MODE == 2) { const int h = n / MLA_QD, j = n - h * MLA_QD; if (j < 128) return n; const int i = j - 128; return h * MLA_QD + 128 + 2 * (i & 31) + (i >> 5); }
    else { if (n < INW - ROPED) return n; const int i = n - (INW - ROPED); return (INW - ROPED) + 2 * (i & 31) + (i >> 5); }
}
struct TrDesc { const gf32* W; gbf16* WT; const gf32* gk; int N, ldt, row_off, mode, k0, n0; };
__device__ __forceinline__ TrDesc tr_desc(const gf32* W, int N, gbf16* WT, int ldt, int row_off, int mode, const gf32* gk, int item) {
    TrDesc d; d.W = W; d.WT = WT; d.gk = gk; d.N = N; d.ldt = ldt; d.row_off = row_off; d.mode = mode; const int nblk = N >> 6, kb = item / nblk, nb = item - kb * nblk; d.k0 = kb << 6; d.n0 = nb << 6; return d;
}
__device__ __forceinline__ int rowmap_rt(int mode, int n, int row_off) { return mode == 0 ? rowmap<0>(n, row_off) : (mode == 1 || mode == 6 || mode == 9 || mode == 10) ? rowmap<1>(n, row_off) : mode == 2 ? rowmap<2>(n, row_off) : rowmap<3>(n, row_off); }
__device__ __forceinline__ void tr_load(const TrDesc& d, f32x4 (&a)[8], f32x4 (&b)[8], f32x2 (&g)[8], int lane) {
    const int l16 = lane & 15, kq = lane >> 4;
    const GAS char* wb = (const GAS char*)d.W + ((size_t)d.k0 * d.N + d.n0) * 4;
    if (d.mode == 4 || d.mode == 5) {
#pragma unroll
        for (int j = 0; j < 4; ++j) { const unsigned off = (unsigned)((4 * (kq + 4 * j)) * d.N + 4 * l16) * 4u, rs = (unsigned)d.N * 4u;
            if (j < 2) { a[4 * j] = __builtin_nontemporal_load((const GAS f32x4*)(wb + off)); a[4 * j + 1] = __builtin_nontemporal_load((const GAS f32x4*)(wb + off + rs)); a[4 * j + 2] = __builtin_nontemporal_load((const GAS f32x4*)(wb + off + 2 * rs)); a[4 * j + 3] = __builtin_nontemporal_load((const GAS f32x4*)(wb + off + 3 * rs)); }
            else { b[4 * j - 8] = __builtin_nontemporal_load((const GAS f32x4*)(wb + off)); b[4 * j - 7] = __builtin_nontemporal_load((const GAS f32x4*)(wb + off + rs)); b[4 * j - 6] = __builtin_nontemporal_load((const GAS f32x4*)(wb + off + 2 * rs)); b[4 * j - 5] = __builtin_nontemporal_load((const GAS f32x4*)(wb + off + 3 * rs)); }
            if (d.gk) { const f32x4 g4 = *(const GAS f32x4*)(d.gk + d.k0 + 4 * (kq + 4 * j)); g[2 * j] = (f32x2){g4[0], g4[1]}; g[2 * j + 1] = (f32x2){g4[2], g4[3]}; } else { g[2 * j] = (f32x2){1.f, 1.f}; g[2 * j + 1] = (f32x2){1.f, 1.f}; } }
        return; }
#pragma unroll
    for (int it = 0; it < 8; ++it) { const int kp = kq + 4 * it; const unsigned off = (unsigned)((2 * kp) * d.N + 4 * l16) * 4u;
        a[it] = __builtin_nontemporal_load((const GAS f32x4*)(wb + off)); b[it] = __builtin_nontemporal_load((const GAS f32x4*)(wb + off + (unsigned)d.N * 4u));
        g[it] = d.gk ? *(const GAS f32x2*)(d.gk + d.k0 + 2 * kp) : (f32x2){1.f, 1.f}; }
}
__device__ __forceinline__ void tr_store(const TrDesc& d, const f32x4 (&a)[8], const f32x4 (&b)[8], const f32x2 (&g)[8], LAS unsigned* T, int lane) {
    const int l16 = lane & 15, kq = lane >> 4;
    if (d.mode == 4 || d.mode == 5) {
        const float fs = d.mode == 4 ? pg8::WD_F8_SCALE : pg8::WGU_F8_SCALE;
#pragma unroll
        for (int j = 0; j < 4; ++j) { const int q = kq + 4 * j; f32x4 r0, r1, r2, r3;
            if (j < 2) { r0 = a[4 * j]; r1 = a[4 * j + 1]; r2 = a[4 * j + 2]; r3 = a[4 * j + 3]; } else { r0 = b[4 * j - 8]; r1 = b[4 * j - 7]; r2 = b[4 * j - 6]; r3 = b[4 * j - 5]; }
            LAS unsigned* t = T + (4 * l16) * 17 + q;
            const f32x4 gq = (f32x4){g[2 * j][0], g[2 * j][1], g[2 * j + 1][0], g[2 * j + 1][1]} * fs;
#pragma unroll
            for (int e = 0; e < 4; ++e) t[17 * e] = pg8::pack4_fp8((f32x4){r0[e], r1[e], r2[e], r3[e]} * gq); }
        LDS_WAIT(); asm volatile("" ::: "memory");
        const int c4 = lane & 3;
#pragma unroll
        for (int jj = 0; jj < 4; ++jj) { const int n = (lane >> 2) + 16 * jj; LAS const unsigned* sp = T + n * 17 + 4 * c4;
            u32x4 o; o.x = sp[0]; o.y = sp[1]; o.z = sp[2]; o.w = sp[3];
            *(GAS u32x4*)((GAS unsigned char*)d.WT + (size_t)(d.mode == 5 ? rowmap<1>(d.n0 + n, d.row_off) : d.row_off + d.n0 + n) * d.ldt + d.k0 + 16 * c4) = o; }
        LDS_WAIT(); asm volatile("" ::: "memory");
        return; }
#pragma unroll
    for (int it = 0; it < 8; ++it) { const int kp = kq + 4 * it; const f32x4 x = a[it] * g[it][0], y = b[it] * g[it][1];
        LAS unsigned* t = T + (4 * l16) * 33 + kp;
        t[0] = cvt_pk_bf16(x[0], y[0]); t[33] = cvt_pk_bf16(x[1], y[1]); t[66] = cvt_pk_bf16(x[2], y[2]); t[99] = cvt_pk_bf16(x[3], y[3]); }
    LDS_WAIT(); asm volatile("" ::: "memory");
    const int c = lane & 7;
#pragma unroll
    for (int j = 0; j < 8; ++j) { const int n = (lane >> 3) + 8 * j; LAS const unsigned* sp = T + n * 33 + 4 * c;
        u32x4 o; o.x = sp[0]; o.y = sp[1]; o.z = sp[2]; o.w = sp[3];
        const int drow = rowmap_rt(d.mode, d.n0 + n, d.row_off);
        if (d.mode == 9 || d.mode == 10 || d.mode == 12) {
            const float cl = ((const GAS float*)((GAS char*)d.WT - (d.mode == 9 ? WS_WGU1Q : d.mode == 10 ? WS_WGU2Q : WS_WINQ) + (d.mode == 9 ? WS_SCW : d.mode == 10 ? WS_SCW2 : WS_SCW3)))[drow] * CLIPF, inv = 127.0f / fmaxf(cl, 1e-30f);
            u32x2 q; q.x = pack4_i8((f32x4){bf_lo(o.x), bf_hi(o.x), bf_lo(o.y), bf_hi(o.y)} * inv); q.y = pack4_i8((f32x4){bf_lo(o.z), bf_hi(o.z), bf_lo(o.w), bf_hi(o.w)} * inv);
            *(GAS u32x2*)((GAS char*)d.WT + (size_t)drow * d.ldt + d.k0 + 8 * c) = q;
            continue; }
        *(GAS u32x4*)(d.WT + (size_t)drow * d.ldt + d.k0 + 8 * c) = o;
        if (d.mode == 1 || d.mode == 6) {
            unsigned mx = max(max(max(o.x & 0x7fff0000u, (o.x << 16) & 0x7fff0000u), max(o.y & 0x7fff0000u, (o.y << 16) & 0x7fff0000u)), max(max(o.z & 0x7fff0000u, (o.z << 16) & 0x7fff0000u), max(o.w & 0x7fff0000u, (o.w << 16) & 0x7fff0000u)));
            mx = max(mx, (unsigned)__shfl_xor((int)mx, 1)); mx = max(mx, (unsigned)__shfl_xor((int)mx, 2)); mx = max(mx, (unsigned)__shfl_xor((int)mx, 4));
            if (c == 0) (void)__hip_atomic_fetch_max((GAS unsigned*)(d.mode == 1 ? (GAS char*)d.WT - WS_WGU1 + WS_SCW : (GAS char*)d.WT - WS_WGU2 + WS_SCW2) + drow, mx, __ATOMIC_RELAXED, __HIP_MEMORY_SCOPE_AGENT); } }
    LDS_WAIT(); asm volatile("" ::: "memory");
}
__device__ __forceinline__ void sample_absmax(const TrDesc& d, GAS unsigned* SC, int lane, int rm) {
    f32x4 a[8], b[8]; f32x2 g[8];
    tr_load(d, a, b, g, lane);
    f32x4 m = {0.f, 0.f, 0.f, 0.f};
#pragma unroll
    for (int it = 0; it < 8; ++it) {
#pragma unroll
        for (int e = 0; e < 4; ++e) m[e] = fmaxf(m[e], fmaxf(__builtin_fabsf(a[it][e] * g[it][0]), __builtin_fabsf(b[it][e] * g[it][1]))); }
#pragma unroll
    for (int e = 0; e < 4; ++e) { m[e] = fmaxf(m[e], __shfl_xor(m[e], 16)); m[e] = fmaxf(m[e], __shfl_xor(m[e], 32)); }
    if (lane < 16) {
#pragma unroll
        for (int e = 0; e < 4; ++e) (void)__hip_atomic_fetch_max(SC + (rm == 1 ? rowmap<1>(d.n0 + 4 * lane + e, d.row_off) : rowmap<3>(d.n0 + 4 * lane + e, d.row_off)), __float_as_uint(m[e]), __ATOMIC_RELAXED, __HIP_MEMORY_SCOPE_AGENT); }
}
#define TR_PIPELINE(first, end, stride, DEC) do { \
    f32x4 a0_[8], b0_[8], a1_[8], b1_[8]; f32x2 g0_[8], g1_[8]; TrDesc d0_, d1_; int it_ = (first); \
    if (it_ < (end)) { d0_ = DEC(it_); tr_load(d0_, a0_, b0_, g0_, lane); } \
    while (it_ < (end)) { int n_ = it_ + (stride); if (n_ < (end)) { d1_ = DEC(n_); tr_load(d1_, a1_, b1_, g1_, lane); } tr_store(d0_, a0_, b0_, g0_, T, lane); it_ = n_; if (it_ >= (end)) break; \
        n_ = it_ + (stride); if (n_ < (end)) { d0_ = DEC(n_); tr_load(d0_, a0_, b0_, g0_, lane); } tr_store(d1_, a1_, b1_, g1_, T, lane); it_ = n_; } } while (0)
#define RSRC(p, bytes) __builtin_amdgcn_make_buffer_rsrc((void*)(p), 0, (int)(bytes), 0x00020000)
__device__ __forceinline__ f32x4 bld16(__amdgpu_buffer_rsrc_t r, int voff, int soff) { return __builtin_bit_cast(f32x4, __builtin_amdgcn_raw_buffer_load_b128(r, voff, soff, 0)); }
__device__ __forceinline__ f32x4 bld16nt(__amdgpu_buffer_rsrc_t r, int voff, int soff) { return __builtin_bit_cast(f32x4, __builtin_amdgcn_raw_buffer_load_b128(r, voff, soff, 2)); }
__device__ __forceinline__ u32x2 bld8(__amdgpu_buffer_rsrc_t r, int voff, int soff) { return __builtin_bit_cast(u32x2, __builtin_amdgcn_raw_buffer_load_b64(r, voff, soff, 0)); }
__device__ __forceinline__ void bst16(f32x4 v, __amdgpu_buffer_rsrc_t r, int voff, int soff) { __builtin_amdgcn_raw_buffer_store_b128(__builtin_bit_cast(u32x4, v), r, voff, soff, 0); }
__device__ __forceinline__ void bst8(u32x2 v, __amdgpu_buffer_rsrc_t r, int voff, int soff) { __builtin_amdgcn_raw_buffer_store_b64(v, r, voff, soff, 0); }
__device__ __forceinline__ void rms_rows_to_bf16(const gf32* x, const gf32* g, gbf16* o, int nrows, int gw, int NGW, int lane) {
    const __amdgpu_buffer_rsrc_t rx = RSRC(x, (size_t)nrows * D * 4), rg = RSRC(g, D * 4), ro = RSRC(o, (size_t)nrows * D * 2);
    const int l16 = lane * 16;
    for (int row = gw; row < nrows; row += NGW) {
        const int o16 = row * (D * 4) + lane * 16, o8 = row * (D * 2) + lane * 8;
        f32x4 v[16]; float s = 0.f;
#pragma unroll
        for (int j = 0; j < 16; ++j) { v[j] = bld16(rx, o16, j * 1024); s += (v[j][0] * v[j][0] + v[j][1] * v[j][1]) + (v[j][2] * v[j][2] + v[j][3] * v[j][3]); }
        const float rstd = rsqrtf(wave_sum(s) * (1.f / D) + EPS);
#pragma unroll
        for (int j = 0; j < 16; ++j) { const f32x4 gg = bld16(rg, l16, j * 1024); u32x2 w; w.x = cvt_pk_bf16(v[j][0] * rstd * gg[0], v[j][1] * rstd * gg[1]); w.y = cvt_pk_bf16(v[j][2] * rstd * gg[2], v[j][3] * rstd * gg[3]); bst8(w, ro, o8, j * 512);
            if ((j & 3) == 3) asm volatile("" ::: "memory"); }
    }
}
__device__ __forceinline__ void x_to_bf16_rs(const gf32* x, gbf16* o, gf32* RS, GAS unsigned char* X8, gf32* RSX, int gw, int NGW, int lane) {
    const __amdgpu_buffer_rsrc_t rx = RSRC(x, (size_t)M * D * 4), ro = RSRC(o, (size_t)M * D * 2), r8 = RSRC(X8, (size_t)M * D);
    for (int row = gw; row < M; row += NGW) {
        const int o16 = row * (D * 4) + lane * 16, o8 = row * (D * 2) + lane * 8, o4 = row * D + lane * 4;
        f32x4 v[16]; float s = 0.f, am = 0.f;
#pragma unroll
        for (int j = 0; j < 16; ++j) { v[j] = bld16nt(rx, o16, j * 1024); }
#pragma unroll
        for (int j = 0; j < 16; ++j) { s += (v[j][0] * v[j][0] + v[j][1] * v[j][1]) + (v[j][2] * v[j][2] + v[j][3] * v[j][3]); u32x2 w; w.x = cvt_pk_bf16(v[j][0], v[j][1]); w.y = cvt_pk_bf16(v[j][2], v[j][3]); bst8(w, ro, o8, j * 512);
            am = fmaxf(fmaxf(am, fmaxf(__builtin_fabsf(v[j][0]), __builtin_fabsf(v[j][1]))), fmaxf(__builtin_fabsf(v[j][2]), __builtin_fabsf(v[j][3]))); }
        const float rstd = rsqrtf(wave_sum(s) * (1.f / D) + EPS);
        am = fmaxf(wave_max(am), 1e-30f);
        const float inv = 127.0f / am;
#pragma unroll
        for (int j = 0; j < 16; ++j) __builtin_amdgcn_raw_buffer_store_b32(pack4_i8(v[j] * inv), r8, o4, j * 256, 0);
        if (lane == 0) { RS[row] = rstd; RSX[row] = rstd * am * (1.0f / 127.0f); }
    }
}
__device__ __forceinline__ void quant_rows_i8(const gbf16* W, GAS unsigned char* Q, const gf32* SC, int nrows, int gw, int NGW, int lane) {
    for (int row = gw; row < nrows; row += NGW) {
        const float inv = 127.0f / fmaxf(SC[row], 1e-30f);
        const GAS u32x4* src = (const GAS u32x4*)(W + (size_t)row * D) + lane; GAS u32x2* dst = (GAS u32x2*)(Q + (size_t)row * D) + lane;
        u32x4 w[8];
#pragma unroll
        for (int j = 0; j < 8; ++j) w[j] = src[j * 64];
#pragma unroll
        for (int j = 0; j < 8; ++j) { u32x2 q; q.x = pack4_i8((f32x4){bf_lo(w[j].x), bf_hi(w[j].x), bf_lo(w[j].y), bf_hi(w[j].y)} * inv); q.y = pack4_i8((f32x4){bf_lo(w[j].z), bf_hi(w[j].z), bf_lo(w[j].w), bf_hi(w[j].w)} * inv); dst[j * 64] = q; }
    }
}
__device__ __forceinline__ void requant_rows_i8(const GAS unsigned char* S, GAS unsigned char* Q, const gf32* ST, gf32* AOUT, int nrows, int gw, int NGW, int lane) {
    for (int row = gw; row < nrows; row += NGW) {
        const float a = ST[(size_t)row * 64 + lane], A = wave_max(a), ratio = a / fmaxf(A, 1e-30f);
        GAS u32x4* p = (GAS u32x4*)(Q + (size_t)row * D) + lane * 4; const GAS u32x4* ps = (const GAS u32x4*)(S + (size_t)row * D) + lane * 4;
        u32x4 w[4];
#pragma unroll
        for (int j = 0; j < 4; ++j) w[j] = ps[j];
#pragma unroll
        for (int j = 0; j < 4; ++j) {
#pragma unroll
            for (int e = 0; e < 4; ++e) { const int x = (int)w[j][e];
                w[j][e] = pack4_i8((f32x4){(float)((x << 24) >> 24), (float)((x << 16) >> 24), (float)((x << 8) >> 24), (float)(x >> 24)} * ratio); }
            p[j] = w[j]; }
        if (lane == 0) AOUT[row] = A;
    }
}
template <int MODE, bool W8 = false> __device__ __forceinline__ void row_phase(const void* hin, const gbf16* F, const gf32* SS, const gf32* gpost, float w, const gf32* gnext,
                                                              gbf16* H, gf32* RS, gf32* out, LAS float* glds, int gw, int NGW, int tid, int lane, GAS unsigned char* H8 = nullptr, gf32* RSQ = nullptr) {
    for (int i = tid; i < D / 4; i += NTHREADS) { ((LAS f32x4*)glds)[i] = ((const GAS f32x4*)gpost)[i]; if (MODE == 2) ((LAS f32x4*)glds)[D / 4 + i] = ((const GAS f32x4*)gnext)[i]; }
    __syncthreads();
    const __amdgpu_buffer_rsrc_t rh = RSRC(hin, (size_t)M * D * (MODE == 0 ? 4 : 2)), rf_ = RSRC(F, (size_t)M * D * 2), ro = RSRC(MODE == 2 ? (void*)out : (void*)H, (size_t)M * D * (MODE == 2 ? 4 : 2));
    for (int row = gw; row < M; row += NGW) {
        const int o16 = row * (D * 4) + lane * 16, o8 = row * (D * 2) + lane * 8;
        const float ssv = SS[(size_t)row * 64 + lane];
        f32x4 v[16]; u32x2 ff[16];
#pragma unroll
        for (int j = 0; j < 16; ++j) { ff[j] = bld8(rf_, o8, j * 512);
            if (MODE == 0) v[j] = bld16nt(rh, o16, j * 1024);
            else { const u32x2 hb = bld8(rh, o8, j * 512); v[j][0] = bf_lo(hb.x); v[j][1] = bf_hi(hb.x); v[j][2] = bf_lo(hb.y); v[j][3] = bf_hi(hb.y); } }
        const float rf = rsqrtf(wave_sum(ssv) * (1.f / D) + EPS) * w;
        float s = 0.f;
#pragma unroll
        for (int j = 0; j < 16; ++j) { const f32x4 g4 = *(LAS const f32x4*)(glds + lane * 4 + j * 256);
            v[j][0] += bf_lo(ff[j].x) * rf * g4[0]; v[j][1] += bf_hi(ff[j].x) * rf * g4[1]; v[j][2] += bf_lo(ff[j].y) * rf * g4[2]; v[j][3] += bf_hi(ff[j].y) * rf * g4[3];
            s += (v[j][0] * v[j][0] + v[j][1] * v[j][1]) + (v[j][2] * v[j][2] + v[j][3] * v[j][3]); }
        const float rstd = rsqrtf(wave_sum(s) * (1.f / D) + EPS);
        if constexpr (MODE == 2) {
#pragma unroll
            for (int j = 0; j < 16; ++j) { const f32x4 g4 = *(LAS const f32x4*)(glds + D + lane * 4 + j * 256); bst16(v[j] * rstd * g4, ro, o16 + j * 1024, 0); } }
        else {
#pragma unroll
            for (int j = 0; j < 16; ++j) { u32x2 wv; wv.x = cvt_pk_bf16(v[j][0], v[j][1]); wv.y = cvt_pk_bf16(v[j][2], v[j][3]); bst8(wv, ro, o8, j * 512); }
            if constexpr (W8) { const __amdgpu_buffer_rsrc_t r8 = RSRC(H8, (size_t)M * D); const int o4 = row * D + lane * 4;
                float am = 0.f;
#pragma unroll
                for (int j = 0; j < 16; ++j) am = fmaxf(fmaxf(am, fmaxf(__builtin_fabsf(v[j][0]), __builtin_fabsf(v[j][1]))), fmaxf(__builtin_fabsf(v[j][2]), __builtin_fabsf(v[j][3])));
                am = fmaxf(wave_max(am), 1e-30f); const float inv = 127.0f / am;
#pragma unroll
                for (int j = 0; j < 16; ++j) __builtin_amdgcn_raw_buffer_store_b32(pack4_i8(v[j] * inv), r8, o4, j * 256, 0);
                if (lane == 0) RSQ[row] = rstd * am * (1.0f / 127.0f); }
            if (lane == 0) RS[row] = rstd; }
    }
}

constexpr int N_PHASES = 16;
constexpr int I_GU_ = (D / 64) * (DFF / 64), I_DN_ = (DFF / 64) * (D / 64);
#ifndef TAIL1
#define TAIL1 4000
#endif
#ifndef TAIL4
#define TAIL4 2000
#endif
#ifndef TAIL13
#define TAIL13 5504
#endif
#ifndef TAIL9
#define TAIL9 3000
#endif
static_assert(TAIL1 + TAIL4 + TAIL9 <= 2 * I_GU_, "tail shares");
__device__ __forceinline__ unsigned long long ptr_ld(volatile LAS unsigned* MISC, int i) { return (unsigned long long)(unsigned)__builtin_amdgcn_readfirstlane(MISC[16 + 2 * i]) | ((unsigned long long)(unsigned)__builtin_amdgcn_readfirstlane(MISC[17 + 2 * i]) << 32); }
#define P_IN(i) ((const gf32*)ptr_ld(MISC, (i)))
__device__ __forceinline__ TrDesc dec_gu2(int q, gu8* ws, volatile LAS unsigned* MISC) {
    constexpr int I_GU = (D / 64) * (DFF / 64);
    return q < I_GU ? tr_desc(P_IN(20), DFF, (gbf16*)(ws + WS_WGU2Q), D, 0, 10, P_IN(23), q) : tr_desc(P_IN(21), DFF, (gbf16*)(ws + WS_WGU2Q), D, 128, 10, P_IN(23), q - I_GU);
}
__device__ __forceinline__ TrDesc dec_dn2(int q, gu8* ws, volatile LAS unsigned* MISC) { return tr_desc(P_IN(22), D, (gbf16*)(ws + WS_WD2), DFF, 0, 4, nullptr, q); }
__device__ __forceinline__ TrDesc dec_p0(int it, gu8* ws, volatile LAS unsigned* MISC) {
    constexpr int I_GU = (D / 64) * (DFF / 64), I_DN = (DFF / 64) * (D / 64), I_IN = (D / 64) * (INW / 64), I_QB = (QRANK / 64) * (QBW / 64), I_KVB = (KVRANK / 64) * (KVBW / 64);
    constexpr int I_OUT = (D / 64) * (D / 64), I_MQ = (D / 64) * (MEMW / 64), I_MKV = (D / 64) * (2 * MEMW / 64), I_MO = (MEMW / 64) * (D / 64);
    int r = it;
    if (r < I_GU) return tr_desc(P_IN(3), DFF, (gbf16*)(ws + WS_WGU1Q), D, 0, 9, P_IN(6), r); r -= I_GU;
    if (r < I_GU) return tr_desc(P_IN(4), DFF, (gbf16*)(ws + WS_WGU1Q), D, 128, 9, P_IN(6), r); r -= I_GU;
    if (r < I_DN) return tr_desc(P_IN(5), D, (gbf16*)(ws + WS_WD1), DFF, 0, 0, nullptr, r); r -= I_DN;
    if (r < I_IN) return (r % (INW / 64)) < NQT0 * 4 ? tr_desc(P_IN(7), INW, (gbf16*)(ws + WS_WIN), D, 0, 3, P_IN(14), r) : tr_desc(P_IN(7), INW, (gbf16*)(ws + WS_WINQ), D, 0, 12, P_IN(14), r); r -= I_IN;
    if (r < I_QB) return tr_desc(P_IN(9), QBW, (gbf16*)(ws + WS_WQB), QRANK, 0, 2, P_IN(8), r); r -= I_QB;
    if (r < I_KVB) return tr_desc(P_IN(11), KVBW, (gbf16*)(ws + WS_WKVB), KVRANK, 0, 0, P_IN(10), r); r -= I_KVB;
    if (r < I_OUT) return tr_desc(P_IN(13), D, (gbf16*)(ws + WS_WOUT), D, 0, 0, nullptr, r); r -= I_OUT;
    if (r < I_MQ) return tr_desc(P_IN(16), MEMW, (gbf16*)(ws + WS_WMQ), D, 0, 0, P_IN(19), r); r -= I_MQ;
    if (r < I_MKV) return tr_desc(P_IN(17), 2 * MEMW, (gbf16*)(ws + WS_WMKV), D, 0, 0, nullptr, r); r -= I_MKV;
    if (r < I_MO) return tr_desc(P_IN(18), D, (gbf16*)(ws + WS_WMO), MEMW, 0, 0, nullptr, r); r -= I_MO;
    if (r < 2 * I_GU - TAIL1 - TAIL4 - TAIL9) return dec_gu2(r + TAIL1 + TAIL4 + TAIL9, ws, MISC); r -= 2 * I_GU - TAIL1 - TAIL4 - TAIL9;
    return dec_dn2(r + TAIL13, ws, MISC);
}
#define DEC_GU2(q) dec_gu2(q, ws, MISC)
#define DEC_DN2(q) dec_dn2(q, ws, MISC)

struct Args { const void* in[25]; float* out; unsigned char* ws; int ph_lo, ph_hi; };
static_assert(sizeof(Args) == 25 * 8 + 8 + 8 + 8, "Args has no padding");

__global__ void __launch_bounds__(NTHREADS, 2) fwd(Args args) {
    extern __shared__ __attribute__((aligned(16))) unsigned char lds_raw[];
    LAS unsigned char* lds = (LAS unsigned char*)lds_raw;
    volatile LAS unsigned* MISC = (volatile LAS unsigned*)(lds + MISC_OFF);
    const int tid = threadIdx.x, lane = tid & 63, wave = __builtin_amdgcn_readfirstlane(tid >> 6);
    const int G = gridDim.x, bx = blockIdx.x, vcu = (G % 8 == 0) ? (bx % 8) * (G / 8) + bx / 8 : bx;
    const int gw = vcu * NWAVES + wave, NGW = G * NWAVES;
    unsigned char* ws = args.ws;
    unsigned* ctl = (unsigned*)(ws + WS_CTL);
    for (int u = tid; u < (LDS_BYTES - RING_BYTES) / 4; u += NTHREADS) ((LAS unsigned*)(lds + RING_BYTES))[u] = 0u;
    __syncthreads();
    XcdBarrier bar; bar.bar = ctl + CW_BAR; bar.x = 0; bar.st = nullptr;
    if (MK_N_LAUNCHES == 1) bar = xcd_barrier_post(ctl + CW_BAR, MISC + 8);
    const int lo = args.ph_lo, hi = args.ph_hi;
#define lane (lane_id_fresh())
#define tid (wave * 64 + lane_id_fresh())
#ifndef PH_MASK
#define PH_MASK 0xFFFF
#endif
#define IN(k) ((((PH_MASK) >> (k)) & 1) && lo <= (k) && (k) < hi)
#ifdef PROBE_SPIN_MASK
    unsigned long long probe_acc = 0ull, probe_t0 = __builtin_amdgcn_s_memrealtime();
#define SEAM(k) do { if (IN(k) && IN((k) + 1)) xcd_barrier(bar); { const unsigned long long t_ = __builtin_amdgcn_s_memrealtime(); if ((PROBE_SPIN_MASK >> (k)) & 1) probe_acc += t_ - probe_t0; probe_t0 = t_; } } while (0)
#else
#define SEAM(k) do { if (IN(k) && IN((k) + 1)) xcd_barrier(bar); } while (0)
#endif

    if (tid < 25) { const unsigned long long p = (unsigned long long)args.in[tid]; MISC[16 + 2 * tid] = (unsigned)p; MISC[17 + 2 * tid] = (unsigned)(p >> 32); }
    if (tid == 25) { const unsigned long long p = (unsigned long long)args.out; MISC[16 + 50] = (unsigned)p; MISC[17 + 50] = (unsigned)(p >> 32); }
    if (tid == 26) { const unsigned long long p = (unsigned long long)args.ws; MISC[16 + 52] = (unsigned)p; MISC[17 + 52] = (unsigned)(p >> 32); }
    __syncthreads();
#define PTR(i) ((unsigned long long)(unsigned)__builtin_amdgcn_readfirstlane(MISC[16 + 2 * (i)]) | ((unsigned long long)(unsigned)__builtin_amdgcn_readfirstlane(MISC[17 + 2 * (i)]) << 32))
#define INF(i) ((const gf32*)PTR(i))
#define WSB ((gu8*)PTR(26))
#define WSP(T, off) ((T*)(WSB + (off)))

    if (IN(0)) {
        gu8* ws = WSB;
        LAS unsigned* T = (LAS unsigned*)(lds + wave * 16384);
        constexpr int I_GU = (D / 64) * (DFF / 64), I_DN = (DFF / 64) * (D / 64), I_IN = (D / 64) * (INW / 64), I_QB = (QRANK / 64) * (QBW / 64), I_KVB = (KVRANK / 64) * (KVBW / 64);
        constexpr int I_OUT = (D / 64) * (D / 64), I_MQ = (D / 64) * (MEMW / 64), I_MKV = (D / 64) * (2 * MEMW / 64), I_MO = (MEMW / 64) * (D / 64);
        constexpr int NITEMS = 4 * I_GU + 2 * I_DN + I_IN + I_QB + I_KVB + I_OUT + I_MQ + I_MKV + I_MO - TAIL1 - TAIL4 - TAIL9 - TAIL13;
#define DEC_P0(it) dec_p0(((it) & 1) ? (NITEMS / 2 + ((it) >> 1)) : ((it) >> 1), ws, MISC)
        for (int it = gw; it < 4 * 4 * (DFF / 64); it += NGW) { const int mtx = it / (4 * (DFF / 64)), r = it - mtx * (4 * (DFF / 64)), sb = r / (DFF / 64), nb = r - sb * (DFF / 64), kb = 5 + 16 * sb + (sb >> 1);
            const TrDesc sd = tr_desc(P_IN(mtx == 0 ? 3 : mtx == 1 ? 4 : mtx == 2 ? 20 : 21), DFF, nullptr, 0, (mtx & 1) * 128, 9, P_IN(mtx < 2 ? 6 : 23), kb * (DFF / 64) + nb);
            sample_absmax(sd, (GAS unsigned*)(ws + (mtx < 2 ? WS_SCW : WS_SCW2)), lane, 1); }
        for (int it = gw; it < 4 * (INW / 64 - NQT0 * 4); it += NGW) { const int nbs = INW / 64 - NQT0 * 4, sb = it / nbs, nb = NQT0 * 4 + (it - sb * nbs), kb = 5 + 16 * sb + (sb >> 1);
            const TrDesc sd = tr_desc(P_IN(7), INW, nullptr, 0, 0, 12, P_IN(14), kb * (INW / 64) + nb);
            sample_absmax(sd, (GAS unsigned*)(ws + WS_SCW3), lane, 3); }
        if (MK_N_LAUNCHES == 1) xcd_barrier(bar);
        TR_PIPELINE(gw, NITEMS, NGW, DEC_P0);
        { GAS u32x4* z = (GAS u32x4*)((gbf16*)(ws + WS_WIN) + (size_t)INW * D); const int nz = (INWP - INW) * D * 2 / 16; for (int i = bx * NTHREADS + tid; i < nz; i += G * NTHREADS) z[i] = (u32x4){0u, 0u, 0u, 0u}; }
        { GAS u32x4* z = (GAS u32x4*)((GAS unsigned char*)(ws + WS_WINQ) + (size_t)INW * D); const int nz = (INWP - INW) * D / 16; for (int i = bx * NTHREADS + tid; i < nz; i += G * NTHREADS) z[i] = (u32x4){0u, 0u, 0u, 0u}; }
        { const GAS int* positions = (const GAS int*)PTR(2); GAS f32x2* ROPE = (GAS f32x2*)(ws + WS_ROPE);
          for (int i = bx * NTHREADS + tid; i < M * 32; i += G * NTHREADS) { const int row = i >> 5, p = i & 31;
            double f = 1.0; for (int q = 0; q < p; ++q) f *= 0.74989420933245582730;
            const float ang = (float)positions[row] * (float)f;
            double rev = (double)ang * 0.15915494309189533577; rev -= __builtin_floor(rev);
            const float rv = (float)rev;
            ROPE[i] = (f32x2){__builtin_amdgcn_cosf(rv), __builtin_amdgcn_sinf(rv)}; } }
        x_to_bf16_rs(INF(0), (gbf16*)(ws + WS_XN), (gf32*)(ws + WS_RS), (GAS unsigned char*)(ws + WS_X8), (gf32*)(ws + WS_RSX), gw, NGW, lane);
        { const gf32* mem = INF(1); const gf32* g = INF(15); gbf16* MEMN = (gbf16*)(ws + WS_MEMN);
          rms_rows_to_bf16(mem, g, MEMN, MEMROWS, gw, NGW, lane); }
    }
    SEAM(0);
    if (IN(1)) { gu8* ws = WSB; pg8::Gemm g{(gbf16*)(ws + WS_X8), (gbf16*)(ws + WS_WGU1Q), M, 2 * DFF, D / 2, D / 2, D / 2}; pg8::StaticOrder S; S.init(M, 2 * DFF, G, bx);
        pg8::EpiSwigluQ<false> E{(GAS unsigned char*)(ws + WS_ACT), DFF, (const gf32*)(ws + WS_RSX), (const gf32*)(ws + WS_SCW)}; pg8::gemm_phase<pg8::EpiSwigluQ<false>, pg8::StaticOrder, true, false, true>(lds, g, S, E, wave);
        const int tw = ((M / 256) * (2 * DFF / 256)) % G;
        if (bx >= tw) { LAS unsigned* T = (LAS unsigned*)(lds + wave * 16384);
            TR_PIPELINE((bx - tw) * NWAVES + wave, TAIL1, (G - tw) * NWAVES, DEC_GU2); } }
    SEAM(1);
    if (IN(2)) { gu8* ws = WSB; pg8::Gemm g{(gbf16*)(ws + WS_ACT), (gbf16*)(ws + WS_WD1), M, D, DFF, DFF, DFF}; pg8::StaticOrder S; S.init(M, D, G, bx); pg8::EpiF E{(gbf16*)(ws + WS_F), D, (gf32*)(ws + WS_SS), 64, 1.0f, nullptr, 1.0f}; pg8::gemm_phase(lds, g, S, E, wave); }
    SEAM(2);
    if (IN(3)) {
#ifdef DBG_DELAY
        { const unsigned long long t0 = __builtin_amdgcn_s_memrealtime(); while (__builtin_amdgcn_s_memrealtime() - t0 < 50000ull) __builtin_amdgcn_s_sleep(8); }
#endif
#ifdef DBG_LINCOPY
        { gu8* ws = WSB; const gbf16* src = (const gbf16*)(ws + WS_F); gf32* o = (gf32*)(ws + WS_H); for (size_t i = (size_t)bx * NTHREADS + tid; i < (size_t)M * D; i += (size_t)G * NTHREADS) o[i] = __uint_as_float(((unsigned)src[i]) << 16); }
#else
        gu8* ws = WSB; row_phase<1, true>((const void*)(ws + WS_XN), (gbf16*)(ws + WS_F), (gf32*)(ws + WS_SS), INF(6) + D, 0.5f, nullptr, (gbf16*)(ws + WS_H), (gf32*)(ws + WS_RS), nullptr, (LAS float*)lds, gw, NGW, tid, lane, (GAS unsigned char*)(ws + WS_H8), (gf32*)(ws + WS_RSX));
#endif
    }
    SEAM(3);
    if (IN(4)) { gu8* ws = WSB;
        { pg8::Gemm g{(gbf16*)(ws + WS_H8), (gbf16*)(ws + WS_WINQ + (size_t)NQT0 * 256 * D), M, INWP - NQT0 * 256, D / 2, D / 2, D / 2}; pg8::StaticOrder S; S.init(M, INWP - NQT0 * 256, G, bx);
          pg8::EpiInProj<true> E{(gbf16*)(ws + WS_U), (gf32*)(ws + WS_SSQ), (gf32*)(ws + WS_SSQ) + (size_t)M * 16, (gbf16*)(ws + WS_KPE), (const GAS f32x2*)(ws + WS_ROPE), 0.08838834764831845f * LOG2E, (const gf32*)(ws + WS_RSX), (const gf32*)(ws + WS_SCW3), NQT0};
          pg8::gemm_phase<pg8::EpiInProj<true>, pg8::StaticOrder, true, false, true>(lds, g, S, E, wave); }
        { pg8::Gemm g{(gbf16*)(ws + WS_H), (gbf16*)(ws + WS_WIN), M, NQT0 * 256, D, D, D}; pg8::StaticOrder S; S.init(M, NQT0 * 256, G, bx);
          pg8::EpiInProj<false> E{(gbf16*)(ws + WS_U), (gf32*)(ws + WS_SSQ), (gf32*)(ws + WS_SSQ) + (size_t)M * 16, (gbf16*)(ws + WS_KPE), (const GAS f32x2*)(ws + WS_ROPE), 0.08838834764831845f * LOG2E, (const gf32*)(ws + WS_RS), nullptr, 0};
          pg8::gemm_phase(lds, g, S, E, wave); }
        const int tw = ((M / 256) * (INWP / 256)) % G, tc = (bx + G - tw) % G;
        { pg8::Gemm g2{(gbf16*)(ws + WS_MEMN), (gbf16*)(ws + WS_WMKV), MEMROWS, 2 * MEMW, D, D, D}; pg8::StaticOrder S2; S2.init(MEMROWS, 2 * MEMW, G, tc);
          pg8::EpiF E2{(gbf16*)(ws + WS_KVM), 2 * MEMW, nullptr, 0, 1.0f, nullptr, 1.0f}; pg8::gemm_phase(lds, g2, S2, E2, wave); }
        if (tw && tc >= 16 && tc < G - tw) { LAS unsigned* T = (LAS unsigned*)(lds + wave * 16384);
            TR_PIPELINE(TAIL1 + (tc - 16) * NWAVES + wave, TAIL1 + TAIL4, (G - tw - 16) * NWAVES, DEC_GU2); }
        else if (!tw || G - tw <= 16) { LAS unsigned* T = (LAS unsigned*)(lds + wave * 16384); TR_PIPELINE(TAIL1 + bx * NWAVES + wave, TAIL1 + TAIL4, G * NWAVES, DEC_GU2); } }
    SEAM(4);
    if (IN(5)) {
        { gu8* ws = WSB; pg8::Gemm g{(gbf16*)(ws + WS_U) + 3 * NAW, (gbf16*)(ws + WS_WQB), M, QBW, QRANK, INWP, QRANK}; pg8::StaticOrder S; S.init(M, QBW, G, bx);
          pg8::EpiQb E{(gbf16*)(ws + WS_QMLA), (gf32*)(ws + WS_SSQ), (const GAS f32x2*)(ws + WS_ROPE), 0.07216878364870323f * LOG2E}; pg8::gemm_phase<pg8::EpiQb, pg8::StaticOrder, false>(lds, g, S, E, wave); }
        { gu8* ws = WSB; pg8::Gemm g{(gbf16*)(ws + WS_U) + 3 * NAW + QRANK, (gbf16*)(ws + WS_WKVB), M, KVBW, KVRANK, INWP, KVRANK}; pg8::StaticOrder S; S.init(M, KVBW, G, (bx + 128) % G);
          pg8::EpiKvb E{(gbf16*)(ws + WS_KVMLA), (gf32*)(ws + WS_SSQ) + (size_t)M * 16}; pg8::gemm_phase<pg8::EpiKvb, pg8::StaticOrder, false>(lds, g, S, E, wave); }
        { gu8* ws = WSB; const gf32* na_rpb = INF(12); const gbf16* U = (const gbf16*)(ws + WS_U); gbf16* OCAT = (gbf16*)(ws + WS_OCAT);
          LAS float* btab = (LAS float*)(lds + 112640);
          for (int un = vcu; un < BATCH * NHEAD * 8; un += G) {
            const int bh = un >> 3, rg = un & 7, b = bh >> 4, h = bh & 15;
            if (tid < 15 * 32) { const int dr = tid >> 5, dc = tid & 31; btab[tid] = dc < 31 ? na_rpb[(h * 15 + dr) * 31 + dc] * LOG2E : 0.f; }
            const int r0 = 4 * rg, KR0 = (r0 - 4 < 0 ? 0 : (r0 - 4 > 24 ? 24 : r0 - 4)), rl = r0 + 3, KR1 = (rl - 4 < 0 ? 0 : (rl - 4 > 24 ? 24 : rl - 4)) + 7;
            const int NT = (KR1 - KR0 + 2) & ~1;
            att::NaCtx nc; const int rw = r0 + (wave >> 1); nc.KR0 = KR0; nc.rw = rw; nc.rs = (rw - 4 < 0 ? 0 : (rw - 4 > 24 ? 24 : rw - 4));
            nc.qc = 32 * (wave & 1) + (lane & 31); nc.cst = (nc.qc - 8 < 0 ? 0 : (nc.qc - 8 > 48 ? 48 : nc.qc - 8)); nc.bias = btab;
            const size_t tok0 = (size_t)b * SEQ;
            att::attn_unit<128, 1, 3>(U + (tok0 + rg * 256) * INWP + h * 128, INWP, U + tok0 * INWP + NAW + h * 128, INWP, nullptr, U + tok0 * INWP + 2 * NAW + h * 128, INWP,
                                   OCAT + (tok0 + rg * 256) * D + h * 128, D, NT, (LAS char*)lds, nc, wave);
          } }
    }
    SEAM(5);
    if (IN(6)) {
        gu8* ws = WSB; const gbf16* QMLA = (const gbf16*)(ws + WS_QMLA); const gbf16* KVMLA = (const gbf16*)(ws + WS_KVMLA); const gbf16* KPE = (const gbf16*)(ws + WS_KPE); gbf16* OCAT = (gbf16*)(ws + WS_OCAT);
        att::NaCtx nc{};
        for (int un = vcu; un < BATCH * NHEAD * 8; un += G) {
            const int bh = un >> 3, qb = un & 7, b = bh >> 4, h = bh & 15; const size_t tok0 = (size_t)b * SEQ;
            att::attn_unit<192, 0, 6>(QMLA + (tok0 + qb * 256) * QBW + h * MLA_QD, QBW, KVMLA + tok0 * KVBW + h * MLA_KVD, KVBW, KPE + tok0 * 64, KVMLA + tok0 * KVBW + h * MLA_KVD + 128, KVBW,
                                   OCAT + (tok0 + qb * 256) * D + NAW + h * 128, D, SEQ / 64, (LAS char*)lds, nc, wave);
        }
    }
    SEAM(6);
    if (IN(7)) { gu8* ws = WSB; pg8::Gemm g{(gbf16*)(ws + WS_OCAT), (gbf16*)(ws + WS_WOUT), M, D, D, D, D}; pg8::StaticOrder S; S.init(M, D, G, bx); pg8::EpiF E{(gbf16*)(ws + WS_F), D, (gf32*)(ws + WS_SS), 64, 1.0f, nullptr, 1.0f}; pg8::gemm_phase(lds, g, S, E, wave); }
    SEAM(7);
    if (IN(8)) { gu8* ws = WSB; row_phase<1>((const void*)(ws + WS_H), (gbf16*)(ws + WS_F), (gf32*)(ws + WS_SS), INF(14) + D, 1.0f, nullptr, (gbf16*)(ws + WS_H), (gf32*)(ws + WS_RS), nullptr, (LAS float*)lds, gw, NGW, tid, lane); }
    SEAM(8);
    if (IN(9)) {
        gu8* ws = WSB;
#pragma unroll
        for (int ks = 0; ks < 4; ++ks) { pg8::Gemm g{(gbf16*)(ws + WS_H) + ks * 1024, (gbf16*)(ws + WS_WMQ) + ks * 1024, M, MEMW, 1024, D, D}; pg8::StaticOrder S; S.init(M, MEMW, G, (bx + 4 * G - 64 * ks) % G);
            pg8::EpiF E{(gbf16*)(ws + WS_QP) + (size_t)ks * M * MEMW, MEMW, nullptr, 0, 1.0f, nullptr, 1.0f}; pg8::gemm_phase<pg8::EpiF, pg8::StaticOrder, false>(lds, g, S, E, wave); }
    }
    SEAM(9);
    if (IN(10)) {
        gu8* ws = WSB; const gbf16* QP = (const gbf16*)(ws + WS_QP); const gbf16* KVM = (const gbf16*)(ws + WS_KVM); gbf16* OM = (gbf16*)(ws + WS_OM);
        att::NaCtx nc{}; nc.qrs = (const gf32*)(ws + WS_RS); nc.qscale = 0.08838834764831845f * LOG2E; nc.qstride = (size_t)M * MEMW;
        for (int un = vcu; un < BATCH * 4 * 8; un += G) {
            const int b = un >> 5, h = (un >> 3) & 3, qb = un & 7; nc.KR0 = b * SEQ + qb * 256;
            att::attn_unit<128, 0, 8, 1>(QP + ((size_t)b * SEQ + qb * 256) * MEMW + h * 128, MEMW, KVM + (size_t)b * MEMLEN * 1024 + h * 256, 1024, nullptr, KVM + (size_t)b * MEMLEN * 1024 + h * 256 + 128, 1024,
                                   OM + ((size_t)b * SEQ + qb * 256) * MEMW + h * 128, MEMW, MEMLEN / 64, (LAS char*)lds, nc, wave);
        }
        if (vcu >= BATCH * 4 * 8 || G <= BATCH * 4 * 8) { LAS unsigned* T = (LAS unsigned*)(lds + wave * 16384);
            const int nb_ = G > 128 ? G - 128 : G, ib_ = G > 128 ? vcu - 128 : vcu;
            TR_PIPELINE(TAIL1 + TAIL4 + ib_ * NWAVES + wave, TAIL1 + TAIL4 + TAIL9, nb_ * NWAVES, DEC_GU2); }
    }
    SEAM(10);
    if (IN(11)) { gu8* ws = WSB; pg8::Gemm g{(gbf16*)(ws + WS_OM), (gbf16*)(ws + WS_WMO), M, D, MEMW, MEMW, MEMW}; pg8::StaticOrder S; S.init(M, D, G, bx); pg8::EpiF E{(gbf16*)(ws + WS_F), D, (gf32*)(ws + WS_SS), 64, 1.0f, nullptr, 1.0f}; pg8::gemm_phase<pg8::EpiF, pg8::StaticOrder, false>(lds, g, S, E, wave); }
    SEAM(11);
    if (IN(12)) { gu8* ws = WSB; row_phase<1, true>((const void*)(ws + WS_H), (gbf16*)(ws + WS_F), (gf32*)(ws + WS_SS), INF(19) + D, 1.0f, nullptr, (gbf16*)(ws + WS_H), (gf32*)(ws + WS_RS), nullptr, (LAS float*)lds, gw, NGW, tid, lane, (GAS unsigned char*)(ws + WS_H8), (gf32*)(ws + WS_RSX)); }
    SEAM(12);
    if (IN(13)) { gu8* ws = WSB; pg8::Gemm g{(gbf16*)(ws + WS_H8), (gbf16*)(ws + WS_WGU2Q), M, 2 * DFF, D / 2, D / 2, D / 2}; pg8::StaticOrder S; S.init(M, 2 * DFF, G, bx);
        pg8::EpiSwigluQ<true> E{(GAS unsigned char*)(ws + WS_ACT), DFF, (const gf32*)(ws + WS_RSX), (const gf32*)(ws + WS_SCW2)}; pg8::gemm_phase<pg8::EpiSwigluQ<true>, pg8::StaticOrder, true, false, true>(lds, g, S, E, wave);
        const int tw = ((M / 256) * (2 * DFF / 256)) % G;
        if (bx >= tw) { LAS unsigned* T = (LAS unsigned*)(lds + wave * 16384);
            TR_PIPELINE((bx - tw) * NWAVES + wave, TAIL13, (G - tw) * NWAVES, DEC_DN2); } }
    SEAM(13);
    if (IN(14)) { gu8* ws = WSB; pg8::Gemm g{(gbf16*)(ws + WS_ACT), (gbf16*)(ws + WS_WD2), M, D, DFF / 2, DFF / 2, DFF / 2}; pg8::StaticOrder S; S.init(M, D, G, bx);
        pg8::EpiF E{(gbf16*)(ws + WS_F), D, (gf32*)(ws + WS_SS), 64, 1.0f, nullptr, 1.0f / (pg8::ACT_F8_SCALE * pg8::WD_F8_SCALE)}; pg8::gemm_phase<pg8::EpiF, pg8::StaticOrder, true, true>(lds, g, S, E, wave); }
    SEAM(14);
    if (IN(15)) { gu8* ws = WSB; row_phase<2>((const void*)(ws + WS_H), (gbf16*)(ws + WS_F), (gf32*)(ws + WS_SS), INF(23) + D, 0.5f, INF(24), nullptr, nullptr, (gf32*)PTR(25), (LAS float*)lds, gw, NGW, tid, lane); }
#ifdef PROBE_SPIN_MASK
    { const unsigned long long t_ = __builtin_amdgcn_s_memrealtime(); if ((PROBE_SPIN_MASK >> 15) & 1) probe_acc += t_ - probe_t0;
      if (bx == 0) { const unsigned long long te = __builtin_amdgcn_s_memrealtime(); while (__builtin_amdgcn_s_memrealtime() - te < probe_acc) __builtin_amdgcn_s_sleep(4); } }
#endif
#ifdef DBG_DUMP
    if (lo == 16) { gu8* ws = WSB; gf32* o = (gf32*)PTR(25);
        if (DBG_DUMP_F32) { const gf32* src = (const gf32*)(ws + DBG_DUMP_OFF); for (size_t i = (size_t)bx * NTHREADS + tid; i < (size_t)M * D; i += (size_t)G * NTHREADS) o[i] = src[i]; }
        else if (DBG_DUMP_ROWPAT) { const gbf16* src = (const gbf16*)(ws + DBG_DUMP_OFF);
            for (int row = gw; row < M; row += NGW) for (int j = 0; j < 16; ++j) { const u32x2 f2 = *(const GAS u32x2*)((const GAS char*)src + (size_t)row * (D * 2) + (unsigned)(lane * 8 + j * 512));
                f32x4 v; v[0] = bf_lo(f2.x); v[1] = bf_hi(f2.x); v[2] = bf_lo(f2.y); v[3] = bf_hi(f2.y); *(GAS f32x4*)((GAS char*)o + (size_t)row * (D * 4) + (unsigned)(lane * 16 + j * 1024)) = v; } }
        else { const gbf16* src = (const gbf16*)(ws + DBG_DUMP_OFF); for (size_t i = (size_t)bx * NTHREADS + tid; i < (size_t)M * D; i += (size_t)G * NTHREADS) o[i] = __uint_as_float(((unsigned)src[i]) << 16); } }
#endif
#undef IN
#undef SEAM
}

extern "C" void kernel_launch(void* const* d_in, const int* in_sizes, int n_in, void* d_out, int out_size, void* d_ws, size_t ws_size, hipStream_t stream) {
    static int grid = 0;
    if (grid == 0) {
        if (n_in != 25 || out_size != M * D || ws_size < WS_END) { fprintf(stderr, "kernel_launch: unexpected shapes (n_in %d, out %d, ws %zu < %zu)\n", n_in, out_size, ws_size, (size_t)WS_END); grid = -1; return; }
        int dev = 0, cus = 0, per_cu = 0;
        if (hipGetDevice(&dev) != hipSuccess || hipDeviceGetAttribute(&cus, hipDeviceAttributeMultiprocessorCount, dev) != hipSuccess) { grid = -1; return; }
        if (hipFuncSetAttribute((const void*)fwd, hipFuncAttributeMaxDynamicSharedMemorySize, LDS_BYTES) != hipSuccess) { fprintf(stderr, "kernel_launch: hipFuncSetAttribute failed\n"); grid = -1; return; }
        if (hipOccupancyMaxActiveBlocksPerMultiprocessor(&per_cu, (const void*)fwd, NTHREADS, LDS_BYTES) != hipSuccess || per_cu < 1) { fprintf(stderr, "kernel_launch: occupancy query says %d blocks per CU\n", per_cu); (void)hipGetLastError(); }
        grid = cus;
    }
    if (grid < 0) return;
    (void)in_sizes;
    if (hipMemsetAsync((char*)d_ws + WS_CTL, 0, CTL_ZERO_BYTES, stream) != hipSuccess) return;
    Args a{};
    for (int i = 0; i < 25; ++i) a.in[i] = d_in[i];
    a.out = (float*)d_out; a.ws = (unsigned char*)d_ws;
    if (MK_N_LAUNCHES == 1) { a.ph_lo = 0; a.ph_hi = N_PHASES; hipLaunchKernelGGL(fwd, dim3(grid), dim3(NTHREADS), LDS_BYTES, stream, a); }
    else {
#ifdef DBG_DUMP
        for (int p = 0; p <= DBG_DUMP; ++p) { a.ph_lo = p; a.ph_hi = p + 1; hipLaunchKernelGGL(fwd, dim3(grid), dim3(NTHREADS), LDS_BYTES, stream, a); }
        a.ph_lo = 16; a.ph_hi = 17; hipLaunchKernelGGL(fwd, dim3(grid), dim3(NTHREADS), LDS_BYTES, stream, a);
#else
        for (int p = 0; p < N_PHASES; ++p) { a.ph_lo = p; a.ph_hi = p + 1; hipLaunchKernelGGL(fwd, dim3(grid), dim3(NTHREADS), LDS_BYTES, stream, a);
#ifdef PROBE_REP
            if ((PROBE_REP >> p) & 1) hipLaunchKernelGGL(fwd, dim3(grid), dim3(NTHREADS), LDS_BYTES, stream, a);
#endif
        }
#endif
    }
    const hipError_t le = hipPeekAtLastError();
    if (le != hipSuccess) fprintf(stderr, "kernel_launch: launch failed: %s\n", hipGetErrorName(le));
}
```
